# Optimizing an MI355X kernel written in HIP

```python
import jax, jax.numpy as jnp
from jax import lax
import numpy as np

D_MODEL = 1024
BATCH = 8
SEQ = 4096
DEPTH = 4

CHUNK = 64
Q_BLOCK = 128
PLE_DIM = 256
D_FF = 2816
CONV_DIM = 512
CONV_GROUPS = 8
CONV_K = 3
N_HEADS = 8
NOPE_DIM = 128
ROPE_DIM = 64
V_DIM = 128
Q_LORA = 384
KV_LORA = 256
ROPE_THETA = 10000.0
EPS = 1e-6
QK_DIM = NOPE_DIM + ROPE_DIM
ATTN_SCALE = QK_DIM ** -0.5
IN_SPLITS = (CONV_DIM, CONV_DIM, CONV_DIM, Q_LORA, KV_LORA, ROPE_DIM, D_MODEL, D_MODEL)
IN_COLS = sum(IN_SPLITS)

kernel_name = "hybrid_conv_mla_macaron_ple_trunk"


def rmsnorm(x, g):
    xf = x.astype(jnp.float32)
    y = xf * lax.rsqrt(jnp.mean(xf * xf, axis=-1, keepdims=True) + EPS)
    return (y * g.astype(jnp.float32)).astype(x.dtype)


def swiglu(x, w_gu, w_down):
    g, u = jnp.split(x @ w_gu, 2, axis=-1)
    return (jax.nn.silu(g) * u) @ w_down


def rope_tables(positions):
    inv_freq = ROPE_THETA ** (-jnp.arange(0, ROPE_DIM, 2, dtype=jnp.float32) / ROPE_DIM)
    ang = positions.astype(jnp.float32)[..., None] * inv_freq
    return jnp.cos(ang), jnp.sin(ang)


def apply_rope(x, cos, sin):
    half = ROPE_DIM // 2
    xf = x.astype(jnp.float32)
    x1, x2 = xf[..., :half], xf[..., half:]
    return jnp.concatenate([x1 * cos - x2 * sin, x2 * cos + x1 * sin], axis=-1).astype(x.dtype)


def short_conv_branch(b_gate, c_gate, v, conv_w, w_conv_out):
    seq = v.shape[1]
    z = c_gate * v
    zp = jnp.pad(z, ((0, 0), (CONV_K - 1, 0), (0, 0)))
    y = conv_w[0] * zp[:, 0:seq]
    for j in range(1, CONV_K):
        y = y + conv_w[j] * zp[:, j:j + seq]
    return (b_gate * y) @ w_conv_out


def block_causal_attention(q_nope, q_rope, k_nope, k_rope, v):
    seq = q_nope.shape[1]
    outs = []
    for i in range(seq // Q_BLOCK):
        q0, q1 = i * Q_BLOCK, (i + 1) * Q_BLOCK
        kn, kr, vb = k_nope[:, :q1], k_rope[:, :q1], v[:, :q1]
        s = (jnp.einsum('bqhd,bkhd->bhqk', q_nope[:, q0:q1], kn)
             + jnp.einsum('bqhd,bkd->bhqk', q_rope[:, q0:q1], kr)).astype(jnp.float32) * ATTN_SCALE
        q_chunk = (q0 + jnp.arange(Q_BLOCK)) // CHUNK
        k_chunk = jnp.arange(q1) // CHUNK
        mask = k_chunk[None, :] <= q_chunk[:, None]
        s = jnp.where(mask, s, -1e30)
        pr = jax.nn.softmax(s, axis=-1).astype(v.dtype)
        outs.append(jnp.einsum('bhqk,bkhd->bqhd', pr, vb))
    return jnp.concatenate(outs, axis=1)


def mla_branch(q_c, kv_c, k_r, q_norm_g, kv_norm_g, w_uq, w_ukv, w_mla_out, cos, sin):
    b, s, _ = q_c.shape
    q = (rmsnorm(q_c, q_norm_g) @ w_uq).reshape(b, s, N_HEADS, QK_DIM)
    q_nope = q[..., :NOPE_DIM]
    q_rope = apply_rope(q[..., NOPE_DIM:], cos[:, :, None, :], sin[:, :, None, :])
    kv = (rmsnorm(kv_c, kv_norm_g) @ w_ukv).reshape(b, s, N_HEADS, NOPE_DIM + V_DIM)
    k_nope, v = kv[..., :NOPE_DIM], kv[..., NOPE_DIM:]
    k_rope = apply_rope(k_r, cos, sin)
    o = block_causal_attention(q_nope, q_rope, k_nope, k_rope, v)
    return o.reshape(b, s, N_HEADS * V_DIM) @ w_mla_out


def setup_inputs(seed: int = 0) -> dict:
    key = jax.random.key(seed)
    ks = jax.random.split(key, 24)
    f32 = jnp.float32

    def w(k, shape, fan_in):
        return jax.random.normal(k, shape, f32) * (fan_in ** -0.5)

    def gain(k, shape):
        return 1.0 + 0.05 * jax.random.normal(k, shape, f32)

    x = jax.random.normal(ks[0], (BATCH, SEQ, D_MODEL), f32)
    p = jax.random.normal(ks[1], (DEPTH, BATCH, SEQ, PLE_DIM), f32)
    offset = jax.random.randint(ks[2], (BATCH, 1), 0, 4096, dtype=jnp.int32)
    positions = offset + jnp.arange(SEQ, dtype=jnp.int32)[None, :]
    return {
        "x": x,
        "p": p,
        "positions": positions,
        "ffn1_norm": gain(ks[3], (DEPTH, D_MODEL)),
        "ffn1_w_gu": w(ks[4], (DEPTH, D_MODEL, 2 * D_FF), D_MODEL),
        "ffn1_w_down": w(ks[5], (DEPTH, D_FF, D_MODEL), D_FF),
        "mix_norm": gain(ks[6], (DEPTH, D_MODEL)),
        "w_in": w(ks[7], (DEPTH, D_MODEL, IN_COLS), D_MODEL),
        "conv_w": w(ks[8], (DEPTH, CONV_K, CONV_DIM), CONV_K),
        "w_conv_out": w(ks[9], (DEPTH, CONV_DIM, D_MODEL), CONV_DIM),
        "q_norm": gain(ks[10], (DEPTH, Q_LORA)),
        "kv_norm": gain(ks[11], (DEPTH, KV_LORA)),
        "w_uq": w(ks[12], (DEPTH, Q_LORA, N_HEADS * QK_DIM), Q_LORA),
        "w_ukv": w(ks[13], (DEPTH, KV_LORA, N_HEADS * (NOPE_DIM + V_DIM)), KV_LORA),
        "w_mla_out": w(ks[14], (DEPTH, N_HEADS * V_DIM, D_MODEL), N_HEADS * V_DIM),
        "w_o": w(ks[15], (DEPTH, D_MODEL, D_MODEL), D_MODEL),
        "ffn2_norm": gain(ks[16], (DEPTH, D_MODEL)),
        "ffn2_w_gu": w(ks[17], (DEPTH, D_MODEL, 2 * D_FF), D_MODEL),
        "ffn2_w_down": w(ks[18], (DEPTH, D_FF, D_MODEL), D_FF),
        "ple_norm": gain(ks[19], (DEPTH, D_MODEL)),
        "w_ple_gate": w(ks[20], (DEPTH, D_MODEL, D_MODEL), D_MODEL),
        "w_ple_proj": w(ks[21], (DEPTH, PLE_DIM, D_MODEL), PLE_DIM),
        "final_norm": gain(ks[22], (D_MODEL,)),
    }


def reference(x, p, positions, ffn1_norm, ffn1_w_gu, ffn1_w_down, mix_norm, w_in, conv_w,
              w_conv_out, q_norm, kv_norm, w_uq, w_ukv, w_mla_out, w_o, ffn2_norm, ffn2_w_gu,
              ffn2_w_down, ple_norm, w_ple_gate, w_ple_proj, final_norm):
    cos, sin = rope_tables(positions)
    split_pts = list(np.cumsum(IN_SPLITS)[:-1])
    h = x
    for i in range(DEPTH):
        h = h + 0.5 * swiglu(rmsnorm(h, ffn1_norm[i]), ffn1_w_gu[i], ffn1_w_down[i])

        u = rmsnorm(h, mix_norm[i])
        b_g, c_g, v_c, q_c, kv_c, k_r, g_conv, g_mla = jnp.split(u @ w_in[i], split_pts, axis=-1)
        y_conv = short_conv_branch(b_g, c_g, v_c, conv_w[i], w_conv_out[i])
        y_mla = mla_branch(q_c, kv_c, k_r, q_norm[i], kv_norm[i], w_uq[i], w_ukv[i],
                           w_mla_out[i], cos, sin)
        merged = jax.nn.sigmoid(g_conv) * y_conv + jax.nn.sigmoid(g_mla) * y_mla
        h = h + merged @ w_o[i]

        h = h + 0.5 * swiglu(rmsnorm(h, ffn2_norm[i]), ffn2_w_gu[i], ffn2_w_down[i])

        gate = jax.nn.sigmoid(rmsnorm(h, ple_norm[i]) @ w_ple_gate[i])
        h = h + gate * (p[i] @ w_ple_proj[i])
    return rmsnorm(h, final_norm)
```

```cpp
#include <hip/hip_runtime.h>
#include <hip/hip_cooperative_groups.h>
#include <cstdio>
#include <cstdint>
namespace cg = cooperative_groups;

constexpr int MTOK = 32768, DM = 1024, DFF = 2816, SEQ = 4096, DEPTH = 4;
constexpr float EPS = 1e-6f;
__constant__ float INV_FREQ[32] = {
 0x1.0000000000000p+0f, 0x1.7ff2220000000p-1f, 0x1.1feb340000000p-1f, 0x1.afd1360000000p-2f, 0x1.43d1360000000p-2f, 0x1.e5a8480000000p-3f, 0x1.6c310e0000000p-3f, 0x1.111aee0000000p-3f,
 0x1.99999a0000000p-4f, 0x1.33281c0000000p-4f, 0x1.ccab860000000p-5f, 0x1.59742a0000000p-5f, 0x1.030dc40000000p-5f, 0x1.8486a00000000p-6f, 0x1.235a720000000p-6f, 0x1.b4f7e20000000p-7f,
 0x1.47ae140000000p-7f, 0x1.eb73600000000p-8f, 0x1.7089380000000p-8f, 0x1.145cee0000000p-8f, 0x1.9e7c6e0000000p-9f, 0x1.36d21a0000000p-9f, 0x1.d22a500000000p-10f, 0x1.5d931c0000000p-10f,
 0x1.0624de0000000p-10f, 0x1.8929180000000p-11f, 0x1.26d42c0000000p-11f, 0x1.ba2e4c0000000p-12f, 0x1.4b96be0000000p-12f, 0x1.f150280000000p-13f, 0x1.74eea60000000p-13f, 0x1.17a8e40000000p-13f};

namespace pg8 {
#define PG8_LAS __attribute__((address_space(3)))
typedef unsigned short bf16_t;
typedef short bf16x8 __attribute__((ext_vector_type(8)));
typedef float f32x4 __attribute__((ext_vector_type(4)));
typedef unsigned u32x4 __attribute__((ext_vector_type(4)));
constexpr int BM = 256, BK = 64, HALF = 128, HTB = HALF * BK * 2  , STAGE_BYTES = 8 * HTB, NXCD = 8, WGM = 8;

__host__ __device__ __forceinline__ int lds_byte(int r, int c) { const int st = (r >> 4) * 2 + (c >> 5), rr = r & 15, cc = c & 31, ob = rr * 64 + cc * 2; return st * 1024 + (ob ^ (((ob >> 9) & 1) << 5)); }
__host__ __device__ __forceinline__ void stage_rc(int b, int& R, int& C) { const int st = b / 1024, sb = b % 1024, swz = sb ^ (((sb >> 9) & 1) << 5); R = (st >> 1) * 16 + swz / 64; C = (st & 1) * 32 + (swz % 64) / 2; }
__host__ __device__ __forceinline__ int perm32(int rho) { const int n = rho >> 4, i = rho & 15; return 8 * (i >> 2) + 4 * n + (i & 3); }

struct Unit { int pm, pn; };
struct Gemm { const bf16_t* A; const bf16_t* Bt; int M, N, K, lda; };

struct StaticOrder {
    int nM, nN, nwg, G, c;
    __host__ __device__ void init(int M, int N, int G_, int c_) { nM = M / BM; nN = N / BM; nwg = nM * nN; G = G_; c = c_; }
    __host__ __device__ bool next(int i, Unit& u) const {
        const long L = (long)i * G + c; if (L >= nwg) return false;
        int wgid = (int)L; { const int q = nwg / NXCD, r = nwg % NXCD, xcd = wgid % NXCD, off = wgid / NXCD; wgid = (xcd < r ? xcd * (q + 1) : r * (q + 1) + (xcd - r) * q) + off; }
        const int nig = WGM * nN, gid = wgid / nig, fm = gid * WGM, gsz = (nM - fm) < WGM ? (nM - fm) : WGM;
        u.pm = fm + ((wgid % nig) % gsz); u.pn = (wgid % nig) / gsz; return true;
    }
    __device__ __forceinline__ void a_ready(const Unit&) const {}
    __device__ __forceinline__ void done(const Unit&) const {}
};

typedef unsigned u32x2 __attribute__((ext_vector_type(2)));
typedef _Float16 h16x8 __attribute__((ext_vector_type(8)));
__device__ __forceinline__ unsigned cvt_pk_bf16(float lo, float hi) { unsigned r; asm volatile("v_cvt_pk_bf16_f32 %0, %1, %2" : "=v"(r) : "v"(lo), "v"(hi)); return r; }
__device__ __forceinline__ float sigm(float x) { return __builtin_amdgcn_rcpf(1.f + __builtin_amdgcn_exp2f(-1.4426950408889634f * x)); }
__device__ __forceinline__ float bf_lo(unsigned w) { return __builtin_bit_cast(float, w << 16); }
__device__ __forceinline__ float bf_hi(unsigned w) { return __builtin_bit_cast(float, w & 0xffff0000u); }
__device__ __forceinline__ u32x4 pack8(const f32x4& a, const f32x4& b) { u32x4 w; w.x = cvt_pk_bf16(a[0], a[1]); w.y = cvt_pk_bf16(a[2], a[3]); w.z = cvt_pk_bf16(b[0], b[1]); w.w = cvt_pk_bf16(b[2], b[3]); return w; }
__device__ __forceinline__ void unpack8(const u32x4& w, f32x4& a, f32x4& b) { a[0] = bf_lo(w.x); a[1] = bf_hi(w.x); a[2] = bf_lo(w.y); a[3] = bf_hi(w.y); b[0] = bf_lo(w.z); b[1] = bf_hi(w.z); b[2] = bf_lo(w.w); b[3] = bf_hi(w.w); }

enum { EPI_GU = 0, EPI_RES = 1, EPI_SPLIT = 2, EPI_UQ = 3, EPI_MO = 4, EPI_CO = 5, EPI_PLE = 6 };
struct Epi {
    int mode; float scale;
    float* h;
    bf16_t* o0; bf16_t* o1; bf16_t* o2; int ld0, ld1, ld2, t1, t2, sig1;
    const bf16_t* g;
    const float* cosT; const float* sinT;
    const float* ssq_in; float* ssq_out; bf16_t* hb; bf16_t* hb2; const bf16_t* hsrc; float* lssq; PG8_LAS float* rl;
    mutable int ui;
    __device__ __forceinline__ void init_acc(f32x4 (&acc)[2][2][4][2], const Unit& u, int wr, int wc, int fr, int fq) const {
        if (mode == EPI_RES) {
            const bf16_t* base = hsrc + (size_t)(u.pm * BM + wr * 64 + fr) * DM + u.pn * BM + wc * 32 + 8 * fq;
            u32x4 t[2][4][2];
#pragma unroll
            for (int ai = 0; ai < 2; ++ai)
#pragma unroll
                for (int m = 0; m < 4; ++m)
#pragma unroll
                    for (int bj = 0; bj < 2; ++bj) t[ai][m][bj] = *(const u32x4*)(base + (size_t)(ai * HALF + m * 16) * DM + bj * HALF);
#pragma unroll
            for (int ai = 0; ai < 2; ++ai)
#pragma unroll
                for (int m = 0; m < 4; ++m)
#pragma unroll
                    for (int bj = 0; bj < 2; ++bj) unpack8(t[ai][m][bj], acc[ai][bj][m][0], acc[ai][bj][m][1]);
        } else {
#pragma unroll
            for (int ai = 0; ai < 2; ++ai)
#pragma unroll
                for (int bj = 0; bj < 2; ++bj)
#pragma unroll
                    for (int m = 0; m < 4; ++m) { acc[ai][bj][m][0] = (f32x4){0.f, 0.f, 0.f, 0.f}; acc[ai][bj][m][1] = (f32x4){0.f, 0.f, 0.f, 0.f}; }
        }
    }
    __device__ __forceinline__ void operator()(f32x4 (&acc)[2][2][4][2], const Unit& u, int wr, int wc, int fr, int fq) const {
        const int row0 = u.pm * BM + wr * 64 + fr;
        float rs[2][4];
        if (ssq_in) {
#pragma unroll
            for (int ai = 0; ai < 2; ++ai)
#pragma unroll
                for (int m = 0; m < 4; ++m) rs[ai][m] = rl[ui * BM + wr * 64 + ai * HALF + m * 16 + fr];
        } else {
#pragma unroll
            for (int ai = 0; ai < 2; ++ai)
#pragma unroll
                for (int m = 0; m < 4; ++m) rs[ai][m] = 1.f;
        }
        ++ui;
        if (mode == EPI_GU) {
            const int col = u.pn * 128 + wc * 32 + 8 * fq;
#pragma unroll
            for (int ai = 0; ai < 2; ++ai)
#pragma unroll
                for (int m = 0; m < 4; ++m) { f32x4 r0, r1;
#pragma unroll
                    for (int j = 0; j < 4; ++j) { const float g0 = acc[ai][0][m][0][j] * rs[ai][m], g1 = acc[ai][0][m][1][j] * rs[ai][m]; r0[j] = g0 * sigm(g0) * (acc[ai][1][m][0][j] * rs[ai][m]); r1[j] = g1 * sigm(g1) * (acc[ai][1][m][1][j] * rs[ai][m]); }
                    *(u32x4*)(o0 + (size_t)(row0 + ai * HALF + m * 16) * DFF + col) = pack8(r0, r1); }
        } else if (mode == EPI_RES) {
#pragma unroll
            for (int ai = 0; ai < 2; ++ai)
#pragma unroll
                for (int m = 0; m < 4; ++m) { const size_t row = (size_t)(row0 + ai * HALF + m * 16); const int col = u.pn * BM + wc * 32 + 8 * fq; float sq = 0.f;
#pragma unroll
                    for (int bj = 0; bj < 2; ++bj) { const f32x4 a = acc[ai][bj][m][0], b = acc[ai][bj][m][1];
                        *(u32x4*)(hb + row * DM + col + bj * HALF) = pack8(a, b);
                        sq += (a[0] * a[0] + a[1] * a[1]) + (a[2] * a[2] + a[3] * a[3]) + (b[0] * b[0] + b[1] * b[1]) + (b[2] * b[2] + b[3] * b[3]); }
                    sq += __shfl_xor(sq, 16); sq += __shfl_xor(sq, 32);
                    if (fq == 0) ssq_out[row * 16 + u.pn * 4 + wc] = sq;
                    }
        } else if (mode == EPI_SPLIT) {
            bf16_t* base; int ld, colt; bool sg = false;
            if (u.pn < t1) { base = o0; ld = ld0; colt = u.pn * BM; } else if (u.pn < t2) { base = o1; ld = ld1; colt = (u.pn - t1) * BM; sg = sig1 != 0; } else { base = o2; ld = ld2; colt = (u.pn - t2) * BM; }
#pragma unroll
            for (int ai = 0; ai < 2; ++ai)
#pragma unroll
                for (int m = 0; m < 4; ++m) { bf16_t* rowp = base + (size_t)(row0 + ai * HALF + m * 16) * ld + colt + wc * 32 + 8 * fq;
#pragma unroll
                    for (int bj = 0; bj < 2; ++bj) { f32x4 a = acc[ai][bj][m][0] * rs[ai][m], b = acc[ai][bj][m][1] * rs[ai][m];
                        if (sg) {
#pragma unroll
                            for (int j = 0; j < 4; ++j) { a[j] = sigm(a[j]); b[j] = sigm(b[j]); } }
                        *(u32x4*)(rowp + bj * HALF) = pack8(a, b);
                        if (lssq && u.pn >= t2) {
                            float sq = (a[0] * a[0] + a[1] * a[1]) + (a[2] * a[2] + a[3] * a[3]) + (b[0] * b[0] + b[1] * b[1]) + (b[2] * b[2] + b[3] * b[3]);
                            sq += __shfl_xor(sq, 16); sq += __shfl_xor(sq, 32);
                            if (fq == 0) lssq[(size_t)(row0 + ai * HALF + m * 16) * 32 + (u.pn - t2) * 8 + bj * 4 + wc] = sq; } } }
        } else if (mode == EPI_UQ) {
            if (u.pn < 4) {
#pragma unroll
                for (int ai = 0; ai < 2; ++ai)
#pragma unroll
                    for (int m = 0; m < 4; ++m) { bf16_t* rowp = o0 + (size_t)(row0 + ai * HALF + m * 16) * 1024 + u.pn * BM + wc * 32 + 8 * fq;
#pragma unroll
                        for (int bj = 0; bj < 2; ++bj) *(u32x4*)(rowp + bj * HALF) = pack8(acc[ai][bj][m][0] * rs[ai][m], acc[ai][bj][m][1] * rs[ai][m]); }
            } else {
                const int i0 = (wc & 1) * 16 + 4 * fq;
#pragma unroll
                for (int ai = 0; ai < 2; ++ai)
#pragma unroll
                    for (int m = 0; m < 4; ++m) { const int row = row0 + ai * HALF + m * 16;
                        const f32x4 cs = *(const f32x4*)(cosT + (size_t)row * 32 + i0), sn = *(const f32x4*)(sinT + (size_t)row * 32 + i0);
#pragma unroll
                        for (int bj = 0; bj < 2; ++bj) { const int head = (u.pn - 4) * 4 + 2 * bj + (wc >> 1);
                            const f32x4 x1 = acc[ai][bj][m][0] * rs[ai][m], x2 = acc[ai][bj][m][1] * rs[ai][m]; const f32x4 y1 = x1 * cs - x2 * sn, y2 = x2 * cs + x1 * sn;
                            bf16_t* p = o1 + (size_t)row * 512 + head * 64 + i0;
                            u32x2 w1, w2; w1.x = cvt_pk_bf16(y1[0], y1[1]); w1.y = cvt_pk_bf16(y1[2], y1[3]); w2.x = cvt_pk_bf16(y2[0], y2[1]); w2.y = cvt_pk_bf16(y2[2], y2[3]);
                            *(u32x2*)p = w1; *(u32x2*)(p + 32) = w2; } }
            }
        } else if (mode == EPI_MO || mode == EPI_CO) {
            const int goff = (mode == EPI_MO) ? 1024 : 0;
#pragma unroll
            for (int ai = 0; ai < 2; ++ai)
#pragma unroll
                for (int m = 0; m < 4; ++m) { const size_t row = (size_t)(row0 + ai * HALF + m * 16); const int col = u.pn * BM + wc * 32 + 8 * fq;
#pragma unroll
                    for (int bj = 0; bj < 2; ++bj) { f32x4 ga, gb; unpack8(*(const u32x4*)(g + row * 2048 + goff + col + bj * HALF), ga, gb);
                        f32x4 a = ga * acc[ai][bj][m][0], b = gb * acc[ai][bj][m][1];
                        bf16_t* p = o0 + row * DM + col + bj * HALF;
                        if (mode == EPI_CO) { f32x4 pa, pb; unpack8(*(const u32x4*)p, pa, pb); a += pa; b += pb; }
                        *(u32x4*)p = pack8(a, b); } }
        } else {
#pragma unroll
            for (int ai = 0; ai < 2; ++ai)
#pragma unroll
                for (int m = 0; m < 4; ++m) { const size_t row = (size_t)(row0 + ai * HALF + m * 16); const int col = u.pn * BM + wc * 32 + 8 * fq; float sq = 0.f;
#pragma unroll
                    for (int bj = 0; bj < 2; ++bj) { f32x4 pa, pb, a, b; unpack8(*(const u32x4*)(g + row * DM + col + bj * HALF), pa, pb); unpack8(*(const u32x4*)(hb + row * DM + col + bj * HALF), a, b);
#pragma unroll
                        for (int j = 0; j < 4; ++j) { a[j] += sigm(acc[ai][bj][m][0][j] * rs[ai][m]) * pa[j]; b[j] += sigm(acc[ai][bj][m][1][j] * rs[ai][m]) * pb[j]; }
                        *(u32x4*)(hb2 + row * DM + col + bj * HALF) = pack8(a, b);
                        sq += (a[0] * a[0] + a[1] * a[1]) + (a[2] * a[2] + a[3] * a[3]) + (b[0] * b[0] + b[1] * b[1]) + (b[2] * b[2] + b[3] * b[3]); }
                    sq += __shfl_xor(sq, 16); sq += __shfl_xor(sq, 32);
                    if (fq == 0) ssq_out[row * 16 + u.pn * 4 + wc] = sq;
                    }
        }
    }
};
template <class Epi, class Sched, bool ALIGN_EPI = false, bool SP2 = false>
__device__ __forceinline__ void gemm_phase(PG8_LAS unsigned char* lds, const Gemm g, const Sched& S, const Epi& E) {
    int tid_ = threadIdx.x; asm volatile("" : "+v"(tid_)); const int tid = tid_, wid = __builtin_amdgcn_readfirstlane(tid >> 6), lane = tid & 63, wr = wid >> 2, wc = wid & 3, fr = lane & 15, fq = lane >> 4;
    const int K = g.K, nt = K / BK;
    unsigned voffA[2], voffB[2];
#pragma unroll
    for (int i = 0; i < 2; ++i) { int R, C; stage_rc(tid * 16 + i * 8192, R, C); const int Rb = true ? ((R & ~31) + perm32(R & 31)) : R;
        voffA[i] = (unsigned)(R * g.lda + C) * 2u; voffB[i] = (unsigned)(Rb * K + C) * 2u; }
    const size_t kstep = (size_t)(BK * 2);
    const size_t hstepA = (size_t)HALF * g.lda * 2, hstep = (size_t)HALF * K * 2;
    const size_t tstepA = 2 * hstepA, tstep = 2 * hstep;
    const unsigned ldsw = (unsigned)wid * 1024u;
    const int aoff = lds_byte(wr * 64 + fr, fq * 8), boff = lds_byte(wc * 32 + fr, fq * 8);
#define PG8_SA(b, h) (((b) * 2 + (h)) * HTB)
#define PG8_SB(b, h) ((4 + (b) * 2 + (h)) * HTB)
#define PG8_STAGE(bufoff, gbase, voff) do { _Pragma("unroll") for (int _i = 0; _i < 2; ++_i) \
        __builtin_amdgcn_global_load_lds((const unsigned*)((const char*)(gbase) + (voff)[_i]), (PG8_LAS unsigned*)(lds + (bufoff) + ldsw + _i * 8192), 16, 0, 0); } while (0)
#define PG8_LDA(dst, b, h) do { _Pragma("unroll") for (int m = 0; m < 4; ++m) _Pragma("unroll") for (int k = 0; k < 2; ++k) dst[m][k] = *(const PG8_LAS bf16x8*)(lds + PG8_SA(b, h) + aoff + m * 2048 + k * 1024); } while (0)
#define PG8_LDB(dst, b, h) do { _Pragma("unroll") for (int n = 0; n < 2; ++n) _Pragma("unroll") for (int k = 0; k < 2; ++k) dst[n][k] = *(const PG8_LAS bf16x8*)(lds + PG8_SB(b, h) + boff + n * 2048 + k * 1024); } while (0)
#define PG8_MMA(ai, bj, At, Bt) do { __builtin_amdgcn_s_setprio(1); _Pragma("unroll") for (int m = 0; m < 4; ++m) _Pragma("unroll") for (int n = 0; n < 2; ++n) _Pragma("unroll") for (int k = 0; k < 2; ++k) \
        acc[ai][bj][m][n] = __builtin_amdgcn_mfma_f32_16x16x32_bf16(Bt[n][k], At[m][k], acc[ai][bj][m][n], 0, 0, 0); __builtin_amdgcn_s_setprio(0); } while (0)
#define PG8_WAIT_V(n) asm volatile("s_waitcnt vmcnt(" #n ")" ::: "memory")
#define PG8_WAIT_L(n) asm volatile("s_waitcnt lgkmcnt(" #n ")" ::: "memory")
#define PG8_BAR __builtin_amdgcn_s_barrier()
#define PG8_SCHED __builtin_amdgcn_sched_barrier(0)
    Unit cur, nxt; int ui = 0;
    if (!S.next(0, cur)) return;
    f32x4 acc[2][2][4][2];
    E.init_acc(acc, cur, wr, wc, fr, fq);
    bf16x8 At[4][2], B0[2][2], B1[2][2];
    const char* cA = (const char*)g.A + (size_t)cur.pm * tstepA; const char* cB = (const char*)g.Bt + (size_t)cur.pn * tstep;
    S.a_ready(cur);
    if constexpr (SP2) {
        PG8_STAGE(PG8_SB(0, 0), cB, voffB); PG8_STAGE(PG8_SB(0, 1), cB + hstep, voffB); PG8_STAGE(PG8_SA(0, 0), cA, voffA); PG8_STAGE(PG8_SA(0, 1), cA + hstepA, voffA);
        if (wr == 1) PG8_BAR;
        PG8_WAIT_V(2); PG8_BAR;
        PG8_STAGE(PG8_SB(1, 0), cB + kstep, voffB); PG8_STAGE(PG8_SA(1, 0), cA + kstep, voffA); PG8_STAGE(PG8_SB(1, 1), cB + hstep + kstep, voffB);
        PG8_WAIT_V(6); PG8_BAR;
    } else {
        PG8_STAGE(PG8_SB(0, 0), cB, voffB); PG8_STAGE(PG8_SA(0, 0), cA, voffA); PG8_STAGE(PG8_SB(0, 1), cB + hstep, voffB); PG8_STAGE(PG8_SA(0, 1), cA + hstepA, voffA);
        if (wr == 1) PG8_BAR;
        PG8_WAIT_V(4); PG8_BAR;
        PG8_STAGE(PG8_SB(1, 0), cB + kstep, voffB); PG8_STAGE(PG8_SA(1, 0), cA + kstep, voffA); PG8_STAGE(PG8_SB(1, 1), cB + hstep + kstep, voffB);
        PG8_WAIT_V(6); PG8_BAR;
    }
    for (;;) {
        const bool has_next = S.next(ui + 1, nxt);
        const char* nA = has_next ? (const char*)g.A + (size_t)nxt.pm * tstepA : cA; const char* nB = has_next ? (const char*)g.Bt + (size_t)nxt.pn * tstep : cB;
        for (int t = 0; t < nt; t += 2) {
            const bool last = (t == nt - 2);
            const char* a1 = cA + (size_t)(t + 1) * kstep;
            const char* a2 = last ? nA : cA + (size_t)(t + 2) * kstep; const char* b2 = last ? nB : cB + (size_t)(t + 2) * kstep;
            const char* a3 = a2 + kstep; const char* b3 = b2 + kstep;
            if (last && has_next) S.a_ready(nxt);
            if constexpr (SP2) {
            PG8_LDB(B0, 0, 0); PG8_LDB(B1, 0, 1); PG8_SCHED; PG8_LDA(At, 0, 0); PG8_STAGE(PG8_SA(1, 1), a1 + hstepA, voffA);
            PG8_WAIT_V(8); PG8_WAIT_L(0); PG8_BAR; PG8_MMA(0, 0, At, B0); PG8_MMA(0, 1, At, B1); PG8_BAR; PG8_SCHED;
            PG8_LDA(At, 0, 1); PG8_STAGE(PG8_SB(0, 0), b2, voffB); PG8_STAGE(PG8_SB(0, 1), b2 + hstep, voffB); PG8_STAGE(PG8_SA(0, 0), a2, voffA);
            PG8_WAIT_V(8); PG8_WAIT_L(0); PG8_BAR; PG8_MMA(1, 0, At, B0); PG8_MMA(1, 1, At, B1); PG8_BAR; PG8_SCHED;
            PG8_LDB(B0, 1, 0); PG8_LDB(B1, 1, 1); PG8_SCHED; PG8_LDA(At, 1, 0); PG8_STAGE(PG8_SA(0, 1), a2 + hstepA, voffA);
            PG8_WAIT_V(8); PG8_WAIT_L(0); PG8_BAR; PG8_MMA(0, 0, At, B0); PG8_MMA(0, 1, At, B1); PG8_BAR; PG8_SCHED;
            PG8_LDA(At, 1, 1); PG8_STAGE(PG8_SB(1, 0), b3, voffB); PG8_STAGE(PG8_SB(1, 1), b3 + hstep, voffB); PG8_STAGE(PG8_SA(1, 0), a3, voffA);
            PG8_WAIT_V(8); PG8_WAIT_L(0); PG8_BAR; PG8_MMA(1, 0, At, B0); PG8_MMA(1, 1, At, B1); PG8_BAR; PG8_SCHED;
            } else {
            PG8_LDB(B0, 0, 0); PG8_SCHED; PG8_LDA(At, 0, 0); PG8_STAGE(PG8_SA(1, 1), a1 + hstepA, voffA);
            PG8_WAIT_L(8); PG8_BAR; PG8_WAIT_L(0); PG8_MMA(0, 0, At, B0); PG8_BAR; PG8_SCHED;
            PG8_LDB(B1, 0, 1); PG8_STAGE(PG8_SB(0, 0), b2, voffB);
            PG8_BAR; PG8_WAIT_L(0); PG8_MMA(0, 1, At, B1); PG8_BAR;
            PG8_LDA(At, 0, 1); PG8_STAGE(PG8_SA(0, 0), a2, voffA);
            PG8_BAR; PG8_WAIT_L(0); PG8_MMA(1, 0, At, B0); PG8_BAR; PG8_SCHED;
            PG8_STAGE(PG8_SB(0, 1), b2 + hstep, voffB);
            PG8_WAIT_V(6); PG8_BAR; PG8_MMA(1, 1, At, B1); PG8_BAR;
            PG8_LDB(B0, 1, 0); PG8_SCHED; PG8_LDA(At, 1, 0); PG8_STAGE(PG8_SA(0, 1), a2 + hstepA, voffA);
            PG8_WAIT_L(8); PG8_BAR; PG8_WAIT_L(0); PG8_MMA(0, 0, At, B0); PG8_BAR; PG8_SCHED;
            PG8_LDB(B1, 1, 1); PG8_STAGE(PG8_SB(1, 0), b3, voffB);
            PG8_BAR; PG8_WAIT_L(0); PG8_MMA(0, 1, At, B1); PG8_BAR;
            PG8_LDA(At, 1, 1); PG8_STAGE(PG8_SA(1, 0), a3, voffA);
            PG8_BAR; PG8_WAIT_L(0); PG8_MMA(1, 0, At, B0); PG8_BAR; PG8_SCHED;
            PG8_STAGE(PG8_SB(1, 1), b3 + hstep, voffB);
            PG8_WAIT_V(6); PG8_BAR; PG8_MMA(1, 1, At, B1); PG8_BAR;
            }
        }
        if constexpr (ALIGN_EPI) { if (wr == 0) PG8_BAR; }
        if constexpr (!false) { E(acc, cur, wr, wc, fr, fq); S.done(cur); }
        if (!has_next) break;
        E.init_acc(acc, nxt, wr, wc, fr, fq);
        cur = nxt; cA = nA; cB = nB; ++ui;
        if constexpr (ALIGN_EPI) { if (wr == 1) PG8_BAR; }
    }
    PG8_WAIT_V(0);
    if constexpr (!ALIGN_EPI) { if (wr == 0) PG8_BAR; }
    PG8_BAR;
    if constexpr (false) { E.fused(acc, cur, wr, wc, fr, fq, lds, wid, lane); S.done(cur); }
#undef PG8_SA
#undef PG8_SB
#undef PG8_STAGE
#undef PG8_LDA
#undef PG8_LDB
#undef PG8_MMA
#undef PG8_WAIT_V
#undef PG8_WAIT_L
#undef PG8_BAR
#undef PG8_SCHED
}
}
namespace att {
using bf16x8 = __attribute__((ext_vector_type(8))) short;
using s16x4  = __attribute__((ext_vector_type(4))) short;
using f32x16 = __attribute__((ext_vector_type(16))) float;
using u32x4  = __attribute__((ext_vector_type(4))) unsigned;
typedef unsigned short bf16_t;
constexpr int NW = 8, QBLK = 32, KVBLK = 64;
constexpr float SCALE = 0.07216878364870322f;
constexpr float THR = 8.f;
constexpr int SHM_V = 16384, SHM_KN = 16384, SHM_KR = 8192;
constexpr int OFF_V = 0, OFF_KN = 2 * SHM_V, OFF_KR = OFF_KN + 2 * SHM_KN, OFF_WS = OFF_KR + 2 * SHM_KR, LDS_BYTES = OFF_WS + NW * 64 * 4;
#define KSWZ(row, colB) ((row) * 256 + ((colB) ^ (((row) & 7) << 4)))
#define KRSWZ(row, colB) ((row) * 128 + ((colB) ^ ((((row) >> 1) & 7) << 4)))
#define SBAR() __builtin_amdgcn_sched_barrier(0)
__device__ __forceinline__ int crow(int r, int hi) { return (r & 3) + 8 * (r >> 2) + 4 * hi; }
__device__ __forceinline__ unsigned cvtpk(float lo, float hi) { unsigned r; asm volatile("v_cvt_pk_bf16_f32 %0, %1, %2" : "=v"(r) : "v"(lo), "v"(hi)); return r; }

__device__ __forceinline__ void partialSM(f32x16& p0, f32x16& p1, float& m_reg, float& mn, float& alpha) {
  constexpr float C = SCALE * 1.4426950408889634f;
  float pmax = p0[0];
#pragma unroll
  for (int r = 1; r < 16; ++r) pmax = fmaxf(pmax, p0[r]);
#pragma unroll
  for (int r = 0; r < 16; ++r) pmax = fmaxf(pmax, p1[r]);
  { auto rr = __builtin_amdgcn_permlane32_swap(__float_as_uint(pmax), __float_as_uint(pmax), false, false);
    pmax = fmaxf(__uint_as_float(rr[0]), __uint_as_float(rr[1])); }
  if (__builtin_expect(__all(pmax - m_reg <= THR / SCALE), 1)) { mn = m_reg; alpha = 1.f; }
  else { mn = fmaxf(m_reg, pmax); alpha = __builtin_amdgcn_exp2f((m_reg - mn) * C); m_reg = mn; }
  float mnC = -mn * C;
#pragma unroll
  for (int r = 0; r < 16; ++r) p0[r] = fmaf(p0[r], C, mnC);
#pragma unroll
  for (int r = 0; r < 16; ++r) p1[r] = fmaf(p1[r], C, mnC);
#pragma unroll
  for (int r = 0; r < 16; ++r) p0[r] = __builtin_amdgcn_exp2f(p0[r]);
}
__device__ __forceinline__ void finishSM(f32x16& p0, f32x16& p1, float alpha, float& l_reg, bf16x8& pa0, bf16x8& pa1, bf16x8& pa2, bf16x8& pa3) {
#pragma unroll
  for (int r = 0; r < 16; ++r) p1[r] = __builtin_amdgcn_exp2f(p1[r]);
  float ps = 0;
#pragma unroll
  for (int r = 0; r < 16; ++r) ps += p0[r];
#pragma unroll
  for (int r = 0; r < 16; ++r) ps += p1[r];
  { auto rr = __builtin_amdgcn_permlane32_swap(__float_as_uint(ps), __float_as_uint(ps), false, false);
    ps = __uint_as_float(rr[0]) + __uint_as_float(rr[1]); }
  l_reg = l_reg * alpha + ps;
#define PK4(P, BASE, OUT) do { unsigned a0 = cvtpk(P[BASE + 0], P[BASE + 1]), a1 = cvtpk(P[BASE + 2], P[BASE + 3]);   \
    unsigned b0 = cvtpk(P[BASE + 4], P[BASE + 5]), b1 = cvtpk(P[BASE + 6], P[BASE + 7]);                              \
    auto r0 = __builtin_amdgcn_permlane32_swap(a0, b0, false, false); auto r1 = __builtin_amdgcn_permlane32_swap(a1, b1, false, false); \
    u32x4 w = {r0[0], r1[0], r0[1], r1[1]}; OUT = *reinterpret_cast<bf16x8*>(&w); } while (0)
  PK4(p0, 0, pa0); PK4(p0, 8, pa1); PK4(p1, 0, pa2); PK4(p1, 8, pa3);
#undef PK4
}
__device__ __forceinline__ void qkt(f32x16& p0, f32x16& p1, const char* Kn, const char* Kr, const bf16x8* qr, int r32, int hi, bool live) {
  if (live) {
    p0 = f32x16{}; p1 = f32x16{};
#pragma unroll
    for (int d0 = 0; d0 < 8; ++d0) { const int cb = (d0 * 16 + hi * 8) * 2;
      bf16x8 b0 = *reinterpret_cast<const bf16x8*>(Kn + KSWZ(r32, cb));
      bf16x8 b1 = *reinterpret_cast<const bf16x8*>(Kn + KSWZ(32 + r32, cb));
      p0 = __builtin_amdgcn_mfma_f32_32x32x16_bf16(b0, qr[d0], p0, 0, 0, 0);
      p1 = __builtin_amdgcn_mfma_f32_32x32x16_bf16(b1, qr[d0], p1, 0, 0, 0); }
#pragma unroll
    for (int d0 = 0; d0 < 4; ++d0) { const int cb = (d0 * 16 + hi * 8) * 2;
      bf16x8 b0 = *reinterpret_cast<const bf16x8*>(Kr + KRSWZ(r32, cb));
      bf16x8 b1 = *reinterpret_cast<const bf16x8*>(Kr + KRSWZ(32 + r32, cb));
      p0 = __builtin_amdgcn_mfma_f32_32x32x16_bf16(b0, qr[8 + d0], p0, 0, 0, 0);
      p1 = __builtin_amdgcn_mfma_f32_32x32x16_bf16(b1, qr[8 + d0], p1, 0, 0, 0); }
  } else {
#pragma unroll
    for (int r = 0; r < 16; ++r) { p0[r] = -1e30f; p1[r] = -1e30f; }
  }
}
__device__ __forceinline__ int v_st(int k, int c) { const int kk = (k & ~0xC) | ((k & 4) << 1) | ((k & 8) >> 1); return ((kk >> 3) * 4 + (c >> 5)) * 512 + ((kk & 7) * 32 + (c & 31)) * 2; }
__device__ __forceinline__ int v_rd_base(int lane) { return ((lane & 3) << 3) | (((lane >> 2) & 3) << 6) | (((lane >> 4) & 1) << 5) | (((lane >> 5) & 1) << 8); }
constexpr int v_rd_off(int d0, int ks, int half) { return d0 * 512 + ks * 4096 + half * 2048; }
template <int OFF> __device__ __forceinline__ s16x4 tr_read(int vb) {
  s16x4 r; asm volatile("ds_read_b64_tr_b16 %0, %1 offset:%2" : "=&v"(r) : "v"(vb), "i"(OFF) : "memory"); return r;
}
template <int D0> __device__ __forceinline__ void pv_one(f32x16& od, int vb, bf16x8 pa0, bf16x8 pa1, bf16x8 pa2, bf16x8 pa3) {
  const s16x4 l0 = tr_read<v_rd_off(D0, 0, 0)>(vb), h0 = tr_read<v_rd_off(D0, 0, 1)>(vb), l1 = tr_read<v_rd_off(D0, 1, 0)>(vb), h1 = tr_read<v_rd_off(D0, 1, 1)>(vb);
  const s16x4 l2 = tr_read<v_rd_off(D0, 2, 0)>(vb), h2 = tr_read<v_rd_off(D0, 2, 1)>(vb), l3 = tr_read<v_rd_off(D0, 3, 0)>(vb), h3 = tr_read<v_rd_off(D0, 3, 1)>(vb);
  asm volatile("s_waitcnt lgkmcnt(0)" ::: "memory"); SBAR();
#define PK(L, H) (bf16x8){L[0], L[1], L[2], L[3], H[0], H[1], H[2], H[3]}
  od = __builtin_amdgcn_mfma_f32_32x32x16_bf16(pa0, PK(l0, h0), od, 0, 0, 0);
  od = __builtin_amdgcn_mfma_f32_32x32x16_bf16(pa1, PK(l1, h1), od, 0, 0, 0);
  od = __builtin_amdgcn_mfma_f32_32x32x16_bf16(pa2, PK(l2, h2), od, 0, 0, 0);
  od = __builtin_amdgcn_mfma_f32_32x32x16_bf16(pa3, PK(l3, h3), od, 0, 0, 0);
#undef PK
}
__device__ __forceinline__ void pv_d0(f32x16* o, int vb, bf16x8 pa0, bf16x8 pa1, bf16x8 pa2, bf16x8 pa3) {
  pv_one<0>(o[0], vb, pa0, pa1, pa2, pa3); pv_one<1>(o[1], vb, pa0, pa1, pa2, pa3); pv_one<2>(o[2], vb, pa0, pa1, pa2, pa3); pv_one<3>(o[3], vb, pa0, pa1, pa2, pa3);
}

__device__ __forceinline__ void attn_unit(int b, int h, int qb, const bf16_t* __restrict__ Q, const bf16_t* __restrict__ QR, const bf16_t* __restrict__ KN, const bf16_t* __restrict__ KR, const bf16_t* __restrict__ V, bf16_t* __restrict__ O, char* lds) {
  int tid_ = threadIdx.x; asm volatile("" : "+v"(tid_)); const int tid = tid_, wid = __builtin_amdgcn_readfirstlane(tid >> 6), lane = tid & 63, r32 = lane & 31, hi = lane >> 5;
  char* V_lds = lds + OFF_V; char* Kn_lds = lds + OFF_KN; char* Kr_lds = lds + OFF_KR;
  float* ws = (float*)(lds + OFF_WS) + wid * 64; float* li_l = ws; float* al_l = ws + 32;
  const long rowbase = (long)b * SEQ; const int q0 = qb * 256;
  const int NT = (q0 + 256) / KVBLK;
  const int NTw = q0 / KVBLK + (wid >> 1) + 1;
  float m_reg = -1e30f, l_reg = 0; f32x16 o[4] = {}; bf16x8 qr[12];
  { const bf16_t* Qw = Q + (rowbase + q0 + wid * QBLK + r32) * 1024 + h * 128 + hi * 8;
    const bf16_t* Qr = QR + (rowbase + q0 + wid * QBLK + r32) * 512 + h * 64 + hi * 8;
#pragma unroll
    for (int d0 = 0; d0 < 8; ++d0) qr[d0] = *reinterpret_cast<const bf16x8*>(Qw + d0 * 16);
#pragma unroll
    for (int d0 = 0; d0 < 4; ++d0) qr[8 + d0] = *reinterpret_cast<const bf16x8*>(Qr + d0 * 16); }
  const bf16_t* Kh = KN + rowbase * 1024 + h * 128; const bf16_t* Vh = V + rowbase * 1024 + h * 128; const bf16_t* Krh = KR + rowbase * 64;
  const int sr = tid >> 4, sc = (tid & 15) * 8, vst0 = v_st(sr, sc), vst1 = v_st(32 + sr, sc);
  const int krr = tid >> 3, krc = (tid & 7) * 8;
  const int vb0 = (int)(uintptr_t)V_lds + v_rd_base(lane);
  bf16x8 vs0, vs1, ks0, ks1, kr0;
#define SLOAD_A(k0) do { vs0 = *reinterpret_cast<const bf16x8*>(&Vh[(long)((k0) + sr) * 1024 + sc]); vs1 = *reinterpret_cast<const bf16x8*>(&Vh[(long)((k0) + 32 + sr) * 1024 + sc]); } while (0)
#define SLOAD_R(k0) do { ks0 = *reinterpret_cast<const bf16x8*>(&Kh[(long)((k0) + sr) * 1024 + sc]); ks1 = *reinterpret_cast<const bf16x8*>(&Kh[(long)((k0) + 32 + sr) * 1024 + sc]); \
    kr0 = *reinterpret_cast<const bf16x8*>(&Krh[(long)((k0) + krr) * 64 + krc]); } while (0)
#define SLOAD(k0) do { SLOAD_A(k0); SLOAD_R(k0); } while (0)
#define SWRITE(bb) do { *(bf16x8*)(V_lds + (bb) * SHM_V + vst0) = vs0; *(bf16x8*)(V_lds + (bb) * SHM_V + vst1) = vs1; \
    *(bf16x8*)(Kn_lds + (bb) * SHM_KN + KSWZ(sr, sc * 2)) = ks0; *(bf16x8*)(Kn_lds + (bb) * SHM_KN + KSWZ(32 + sr, sc * 2)) = ks1; \
    *(bf16x8*)(Kr_lds + (bb) * SHM_KR + KRSWZ(krr, krc * 2)) = kr0; } while (0)
#define SWAIT() asm volatile("s_waitcnt vmcnt(0)" ::: "memory")
#define RESC(a) do { if (__any((a) < 1.f)) { if (hi == 0) al_l[r32] = (a); asm volatile("s_waitcnt lgkmcnt(0)" ::: "memory"); \
    _Pragma("unroll") for (int d = 0; d < 4; ++d) _Pragma("unroll") for (int r = 0; r < 16; ++r) o[d][r] *= al_l[crow(r, hi)]; } } while (0)
  f32x16 pA0, pA1, pB0, pB1; float mnA, mnB, alA, alB; bf16x8 pa0, pa1, pa2, pa3;
  SLOAD(0); SWAIT(); SWRITE(0); SLOAD(KVBLK); __syncthreads();
  qkt(pA0, pA1, Kn_lds, Kr_lds, qr, r32, hi, true); partialSM(pA0, pA1, m_reg, mnA, alA);
  SWAIT(); SWRITE(1); __syncthreads();
  for (int j = 1; j + 1 < NT; j += 2) {
    SBAR(); SLOAD_A((j + 1) * KVBLK); SBAR();
    qkt(pB0, pB1, Kn_lds + SHM_KN, Kr_lds + SHM_KR, qr, r32, hi, j < NTw);
    finishSM(pA0, pA1, alA, l_reg, pa0, pa1, pa2, pa3); SBAR();
    SLOAD_R((j + 1) * KVBLK); SBAR();
    pv_d0(o, vb0, pa0, pa1, pa2, pa3); partialSM(pB0, pB1, m_reg, mnB, alB);
    __syncthreads(); SWAIT(); SWRITE(0);
    RESC(alB); __syncthreads();
    SBAR(); SLOAD_A((j + 2) * KVBLK); SBAR();
    qkt(pA0, pA1, Kn_lds, Kr_lds, qr, r32, hi, j + 1 < NTw);
    finishSM(pB0, pB1, alB, l_reg, pa0, pa1, pa2, pa3); SBAR();
    SLOAD_R((j + 2) * KVBLK); SBAR();
    pv_d0(o, vb0 + SHM_V, pa0, pa1, pa2, pa3); partialSM(pA0, pA1, m_reg, mnA, alA);
    __syncthreads(); SWAIT(); SWRITE(1);
    RESC(alA); __syncthreads();
  }
  SBAR(); qkt(pB0, pB1, Kn_lds + SHM_KN, Kr_lds + SHM_KR, qr, r32, hi, NT - 1 < NTw);
  finishSM(pA0, pA1, alA, l_reg, pa0, pa1, pa2, pa3); SBAR();
  pv_d0(o, vb0, pa0, pa1, pa2, pa3); partialSM(pB0, pB1, m_reg, mnB, alB);
  __syncthreads(); RESC(alB);
  finishSM(pB0, pB1, alB, l_reg, pa0, pa1, pa2, pa3); SBAR();
  pv_d0(o, vb0 + SHM_V, pa0, pa1, pa2, pa3);
  if (hi == 0) li_l[r32] = l_reg; asm volatile("s_waitcnt lgkmcnt(0)" ::: "memory");
  float rli[16];
#pragma unroll
  for (int r = 0; r < 16; ++r) rli[r] = __builtin_amdgcn_rcpf(li_l[crow(r, hi)]);
  bf16_t* Ow = O + (rowbase + q0 + wid * QBLK) * 1024 + h * 128;
#pragma unroll
  for (int r = 0; r < 16; ++r) { const int orow = crow(r, hi);
#pragma unroll
    for (int d0 = 0; d0 < 4; ++d0) { const float v = o[d0][r] * rli[r]; Ow[(long)orow * 1024 + d0 * 32 + r32] = (bf16_t)(cvtpk(v, v) & 0xffffu); } }
#undef SLOAD
#undef SLOAD_A
#undef SLOAD_R
#undef SWRITE
#undef SWAIT
#undef RESC
}
#undef SBAR
}
typedef unsigned short bf16;
typedef unsigned v4u __attribute__((ext_vector_type(4)));
typedef unsigned v2u __attribute__((ext_vector_type(2)));
typedef float f32x4 __attribute__((ext_vector_type(4)));
#define LAS __attribute__((address_space(3)))
constexpr size_t MiB = 1u << 20;
#define XB_TMO      128
#define XB_XCNT(j)  (256  + 64 * (j))
#define XB_XSUB(j)  (1280 + 64 * (j))
#define XB_XGEN(j)  (2304 + 64 * (j))
#define XB_TOP      3328
#define XB_TOPGEN   3392
#define XCD_BAR_WORDS 3456
#define XB_SPIN_CAP (1u << 18)

__device__ __forceinline__ unsigned xb_ld(unsigned* p)              { return __hip_atomic_load(p, __ATOMIC_RELAXED, __HIP_MEMORY_SCOPE_AGENT); }
__device__ __forceinline__ unsigned xb_add(unsigned* p, unsigned v) { return __hip_atomic_fetch_add(p, v, __ATOMIC_RELAXED, __HIP_MEMORY_SCOPE_AGENT); }
__device__ __forceinline__ unsigned xb_xcc_id() { return (unsigned)__builtin_amdgcn_s_getreg((3 << 11) | 20) & 0xFu; }
#define XB_SPIN(cond, bar) do { unsigned _sp = 0; while (cond) { __builtin_amdgcn_s_sleep(1); \
    if ((++_sp & 255u) == 0u) { if (xb_ld(&(bar)[XB_TMO])) break; if (_sp > XB_SPIN_CAP) { atomicAdd(&(bar)[XB_TMO], 1u); break; } } } } while (0)

struct XcdBarrier {
    unsigned* bar; unsigned x;
    volatile LAS unsigned* st;
};

__device__ __forceinline__ XcdBarrier xcd_barrier_post(unsigned* bar, volatile LAS unsigned* st) {
    XcdBarrier b; b.bar = bar; b.x = xb_xcc_id(); b.st = st;
    if (threadIdx.x == 0) (void)xb_add(&bar[XB_XCNT(b.x)], 1u);
    return b;
}
__device__ __forceinline__ void xcd_barrier_complete(unsigned* bar, unsigned x, unsigned& nloc, unsigned& nx) {
    const unsigned G = gridDim.x * gridDim.y * gridDim.z;
    unsigned sum, cnt, mine, sp = 0u;
    for (;;) {
        sum = 0u; cnt = 0u; mine = 0u;
#pragma unroll
        for (unsigned j = 0; j < 16; ++j) { const unsigned c = xb_ld(&bar[XB_XCNT(j)]); sum += c; cnt += (c > 0u) ? 1u : 0u; mine = (j == x) ? c : mine; }
        if (sum == G) break;
        __builtin_amdgcn_s_sleep(1);
        if ((++sp & 255u) == 0u) { if (xb_ld(&bar[XB_TMO])) break; if (sp > XB_SPIN_CAP) { atomicAdd(&bar[XB_TMO], 1u); break; } }
    }
    nloc = mine > 0u ? mine : 1u; nx = cnt > 0u ? cnt : 1u;
}

__device__ __forceinline__ void xcd_barrier(const XcdBarrier& b) {
    asm volatile("s_waitcnt vmcnt(0)" ::: "memory");
    __syncthreads();
    if (threadIdx.x == 0) {
        unsigned* bar = b.bar;
        __builtin_amdgcn_s_waitcnt(0);
        unsigned nloc = b.st[0], nx = b.st[1];
        if (nloc == 0u) { xcd_barrier_complete(bar, b.x, nloc, nx); b.st[0] = nloc; b.st[1] = nx; }
        const unsigned old = xb_add(&bar[XB_XSUB(b.x)], 1u);
        const unsigned gen = old / nloc;
        if (old + 1u == (gen + 1u) * nloc) {
            __builtin_amdgcn_fence(__ATOMIC_RELEASE, "agent");
            asm volatile("s_waitcnt vmcnt(0)" ::: "memory");
            const unsigned og = xb_add(&bar[XB_TOP], 1u);
            const unsigned tg = og / nx;
            if (og + 1u == (tg + 1u) * nx) xb_add(&bar[XB_TOPGEN], 1u);
            else XB_SPIN(xb_ld(&bar[XB_TOPGEN]) == tg, bar);
            __builtin_amdgcn_fence(__ATOMIC_ACQUIRE, "agent");
            xb_add(&bar[XB_XGEN(b.x)], 1u);
            asm volatile("s_waitcnt vmcnt(0)" ::: "memory");
        } else {
            XB_SPIN(xb_ld(&bar[XB_XGEN(b.x)]) == gen, bar);
            __builtin_amdgcn_fence(__ATOMIC_ACQUIRE, "agent");
            asm volatile("s_waitcnt vmcnt(0)" ::: "memory");
        }
    }
    __syncthreads();
}

constexpr size_t WS_CTL = 0, CTL_ZERO_BYTES = 16384;
constexpr size_t WS_COS = 1 * MiB, WS_SIN = 5 * MiB, WS_W = 10 * MiB;
constexpr size_t WS_SSQ = 604 * MiB;
constexpr size_t WS_XN = 64 * MiB;
constexpr size_t WS_CONV = 128 * MiB;
constexpr size_t WS_Q = WS_CONV, WS_PB = WS_CONV, WS_PP = WS_CONV + 16 * MiB;
constexpr size_t WS_LORA = 224 * MiB;
constexpr size_t WS_QN = 272 * MiB;
constexpr size_t WS_KVN = 296 * MiB;
constexpr size_t WS_ATTN = 224 * MiB;
constexpr size_t WS_GATES = 312 * MiB;
constexpr size_t WS_YCB = 440 * MiB;
constexpr size_t WS_KROPE = 472 * MiB;
constexpr size_t WS_KNOPE = 476 * MiB;
constexpr size_t WS_V = 540 * MiB;
constexpr size_t WS_HB = WS_V;
constexpr size_t WS_HID = 312 * MiB;
constexpr size_t WS_LSSQ = 638 * MiB;
constexpr size_t WS_END = 642 * MiB;
constexpr size_t WO_GU1 = 0, WO_DN1 = WO_GU1 + (size_t)5632 * 1024 * 2, WO_IN = WO_DN1 + (size_t)1024 * 2816 * 2, WO_CO = WO_IN + (size_t)4352 * 1024 * 2,
    WO_UQ = WO_CO + (size_t)1024 * 512 * 2, WO_UKV = WO_UQ + (size_t)1536 * 384 * 2, WO_MO = WO_UKV + (size_t)2048 * 256 * 2, WO_WO = WO_MO + (size_t)1024 * 1024 * 2,
    WO_GU2 = WO_WO + (size_t)1024 * 1024 * 2, WO_DN2 = WO_GU2 + (size_t)5632 * 1024 * 2, WO_PG = WO_DN2 + (size_t)1024 * 2816 * 2, WO_PP = WO_PG + (size_t)1024 * 1024 * 2,
    WO_END = WO_PP + (size_t)1024 * 256 * 2;
static_assert(WS_W + WO_END <= WS_XN && WS_SSQ + 17 * (size_t)MTOK * 64 <= WS_END, "weights / ssq fit");

constexpr int NWAVES = 8, LDS_BYTES = 147456, RING_BYTES = 131072, MISC_OFF = RING_BYTES + 320;

struct Args { const float* in[23]; float* out; unsigned char* ws; };

__device__ __forceinline__ float wave_sum(float v) {
#pragma unroll
    for (int o = 1; o < 64; o <<= 1) v += __shfl_xor(v, o);
    return v;
}
__device__ __forceinline__ unsigned pk2(float lo, float hi) { return pg8::cvt_pk_bf16(lo, hi); }

template <int TYPE> __device__ __forceinline__ int map_src(int n) {
    if (TYPE == 0) return n;
    if (TYPE == 1) { const int pn = n >> 8, w = n & 255; return (w < 128) ? pn * 128 + w : 2816 + pn * 128 + (w - 128); }
    if (TYPE == 2) { if (n < 1536) return n; if (n < 3584) return n - 1536 + 2240; if (n < 4288) return n - 3584 + 1536; return -1; }
    if (TYPE == 3) { if (n < 1024) return (n >> 7) * 192 + (n & 127);
        const int m = n - 1024, head = m >> 6, w = m & 63, grp = w >> 5, within = w & 31, fqq = within >> 3, nn = (within >> 2) & 1, j = within & 3, i = grp * 16 + 4 * fqq + j;
        return head * 192 + 128 + (nn ? 32 : 0) + i; }
      { if (n < 1024) return (n >> 7) * 256 + (n & 127); const int m = n - 1024; return (m >> 7) * 256 + 128 + (m & 127); }
}
template <int TYPE, bool HASG, bool HALVE = false> __device__ __forceinline__ void cvt_item(const float* W, const float* gain, int K, int Nsrc, int Ndst, bf16* WT, LAS float* scr, int item, int lane) {
    const int nblk = Ndst / 64, kb = item / nblk, nb = item % nblk, k0 = 64 * kb, n0 = 64 * nb;
    const int n4 = (lane & 15) * 4, kq = lane >> 4;
    const int src = map_src<TYPE>(n0 + n4);
    const float* wp = W + (size_t)(k0 + kq) * Nsrc + (src >= 0 ? src : 0);
#pragma unroll 8
    for (int it = 0; it < 16; ++it) { const int kk = kq + 4 * it;
        f32x4 v = (src >= 0) ? __builtin_nontemporal_load((const f32x4*)(wp + (size_t)(4 * it) * Nsrc)) : (f32x4){0.f, 0.f, 0.f, 0.f};
        if (HASG) v = v * gain[k0 + kk]; if (HALVE) v = v * 0.5f;
        scr[kk * 64 + ((n4 + 0) ^ kk)] = v.x; scr[kk * 64 + ((n4 + 1) ^ kk)] = v.y; scr[kk * 64 + ((n4 + 2) ^ kk)] = v.z; scr[kk * 64 + ((n4 + 3) ^ kk)] = v.w; }
    asm volatile("s_waitcnt lgkmcnt(0)" ::: "memory");
    const int c = lane & 7;
#pragma unroll
    for (int j = 0; j < 8; ++j) { const int n = (lane >> 3) + 8 * j; float t[8];
#pragma unroll
        for (int i = 0; i < 8; ++i) t[i] = scr[(8 * c + i) * 64 + (n ^ (8 * c + i))];
        v4u o; o.x = pk2(t[0], t[1]); o.y = pk2(t[2], t[3]); o.z = pk2(t[4], t[5]); o.w = pk2(t[6], t[7]);
        *(v4u*)(WT + (size_t)(n0 + n) * K + k0 + 8 * c) = o; }
    asm volatile("s_waitcnt lgkmcnt(0)" ::: "memory");
}
__device__ __forceinline__ void x_row(const float* xrow, bf16* hbrow, float* ssq, int lane) {
    const f32x4* xr = (const f32x4*)xrow + lane;
    f32x4 v[4]; float s = 0.f;
#pragma unroll
    for (int j = 0; j < 4; ++j) { v[j] = xr[64 * j]; s += (v[j].x * v[j].x + v[j].y * v[j].y) + (v[j].z * v[j].z + v[j].w * v[j].w); }
    unsigned long long* o8 = (unsigned long long*)hbrow + lane;
#pragma unroll
    for (int j = 0; j < 4; ++j) o8[64 * j] = (unsigned long long)pk2(v[j].x, v[j].y) | ((unsigned long long)pk2(v[j].z, v[j].w) << 32);
    s = wave_sum(s);
    if (lane < 16) ssq[lane] = (lane == 0) ? s : 0.f;
}
#define CVT_WEIGHTS(LL, WANT_PG, WANT_REST) do                 { \
                    LAS float* scr = (LAS float*)((LAS unsigned char*)lds + wave * 16384); \
                    constexpr int I_GU = 16 * 88, I_DN = 44 * 16, I_IN = 16 * 68, I_CO = 8 * 16, I_UQ = 6 * 24, I_UKV = 4 * 32, I_SQ = 16 * 16, I_PP = 4 * 16; \
                    constexpr int NITEMS = 2 * I_GU + 2 * I_DN + I_IN + I_CO + I_UQ + I_UKV + 3 * I_SQ + I_PP; \
                    const size_t L = (size_t)(LL); \
                    for (int it = gw; it < NITEMS; it += NGW) { \
                        int r = it; \
                        if (r < I_GU) { if (WANT_REST) cvt_item<1, true>(INP(4) + L * 1024 * 5632, INP(3) + L * 1024, 1024, 5632, 5632, (bf16*)(WB + WO_GU1), scr, r, lane); continue; } r -= I_GU; \
                        if (r < I_GU) { if (WANT_REST) cvt_item<1, true>(INP(17) + L * 1024 * 5632, INP(16) + L * 1024, 1024, 5632, 5632, (bf16*)(WB + WO_GU2), scr, r, lane); continue; } r -= I_GU; \
                        if (r < I_DN) { if (WANT_REST) cvt_item<0, false, true>(INP(5) + L * 2816 * 1024, nullptr, 2816, 1024, 1024, (bf16*)(WB + WO_DN1), scr, r, lane); continue; } r -= I_DN; \
                        if (r < I_DN) { if (WANT_REST) cvt_item<0, false, true>(INP(18) + L * 2816 * 1024, nullptr, 2816, 1024, 1024, (bf16*)(WB + WO_DN2), scr, r, lane); continue; } r -= I_DN; \
                        if (r < I_IN) { if (WANT_REST) cvt_item<2, true>(INP(7) + L * 1024 * 4288, INP(6) + L * 1024, 1024, 4288, 4352, (bf16*)(WB + WO_IN), scr, r, lane); continue; } r -= I_IN; \
                        if (r < I_CO) { if (WANT_REST) cvt_item<0, false>(INP(9) + L * 512 * 1024, nullptr, 512, 1024, 1024, (bf16*)(WB + WO_CO), scr, r, lane); continue; } r -= I_CO; \
                        if (r < I_UQ) { if (WANT_REST) cvt_item<3, true>(INP(12) + L * 384 * 1536, INP(10) + L * 384, 384, 1536, 1536, (bf16*)(WB + WO_UQ), scr, r, lane); continue; } r -= I_UQ; \
                        if (r < I_UKV) { if (WANT_REST) cvt_item<4, true>(INP(13) + L * 256 * 2048, INP(11) + L * 256, 256, 2048, 2048, (bf16*)(WB + WO_UKV), scr, r, lane); continue; } r -= I_UKV; \
                        if (r < I_SQ) { if (WANT_REST) cvt_item<0, false>(INP(14) + L * 1024 * 1024, nullptr, 1024, 1024, 1024, (bf16*)(WB + WO_MO), scr, r, lane); continue; } r -= I_SQ; \
                        if (r < I_SQ) { if (WANT_REST) cvt_item<0, false>(INP(15) + L * 1024 * 1024, nullptr, 1024, 1024, 1024, (bf16*)(WB + WO_WO), scr, r, lane); continue; } r -= I_SQ; \
                        if (r < I_SQ) { if (WANT_PG) cvt_item<0, true>(INP(20) + L * 1024 * 1024, INP(19) + L * 1024, 1024, 1024, 1024, (bf16*)(WB + WO_PG), scr, r, lane); continue; } r -= I_SQ; \
                        if (WANT_REST) cvt_item<0, false>(INP(21) + L * 256 * 1024, nullptr, 256, 1024, 1024, (bf16*)(WB + WO_PP), scr, r, lane); \
                    } \
                } while (0)
__global__ void __launch_bounds__(NWAVES * 64, 2) mega_fwd(Args a) {
    extern __shared__ __attribute__((aligned(16))) unsigned char lds[];
    cg::grid_group grid = cg::this_grid();
    const int G = gridDim.x, bx = blockIdx.x, NGW = G * NWAVES;
    const int vcu = (G % 8 == 0) ? (bx % 8) * (G / 8) + bx / 8 : bx;
#define INP(k) ({ int _k = (k); asm volatile("" : "+s"(_k)); a.in[_k]; })
    float* h = a.out;

    for (int u = threadIdx.x; u < (LDS_BYTES - RING_BYTES) / 4; u += NWAVES * 64) ((LAS unsigned*)((LAS unsigned char*)lds + RING_BYTES))[u] = 0u;
    __syncthreads();
    const XcdBarrier bar = xcd_barrier_post((unsigned*)(a.ws + WS_CTL), (volatile LAS unsigned*)((LAS unsigned char*)lds + MISC_OFF) + 8);
    for (int layer = 0; layer < DEPTH; ++layer) {
        for (int step = 0; step < 12; ++step) {
    unsigned char* ws = a.ws; asm volatile("" : "+s"(ws));
    int tid_ = threadIdx.x; asm volatile("" : "+v"(tid_)); const int tid = tid_, lane = tid & 63, wave = __builtin_amdgcn_readfirstlane(tid >> 6), gw = bx * NWAVES + wave;
    float* cosT = (float*)(ws + WS_COS); float* sinT = (float*)(ws + WS_SIN); float* SSQ = (float*)(ws + WS_SSQ);
    bf16* XN = (bf16*)(ws + WS_XN); bf16* CONV = (bf16*)(ws + WS_CONV); bf16* QB = (bf16*)(ws + WS_Q); bf16* PB = (bf16*)(ws + WS_PB); bf16* PP = (bf16*)(ws + WS_PP);
    bf16* LORA = (bf16*)(ws + WS_LORA); bf16* QN = (bf16*)(ws + WS_QN); bf16* KVN = (bf16*)(ws + WS_KVN); bf16* ATT = (bf16*)(ws + WS_ATTN);
    bf16* GATES = (bf16*)(ws + WS_GATES); bf16* YCB = (bf16*)(ws + WS_YCB); bf16* KROPE = (bf16*)(ws + WS_KROPE); bf16* KNOPE = (bf16*)(ws + WS_KNOPE);
    bf16* QNP = (bf16*)((unsigned char*)h + (size_t)MTOK * DM * 2); bf16* QRP = (bf16*)(ws + WS_XN);     float* LSSQ = (float*)(ws + WS_LSSQ); bf16* VB = (bf16*)(ws + WS_V); bf16* HID = (bf16*)(ws + WS_HID); bf16* HB = (bf16*)h;     bf16* HB2 = XN;
    unsigned char* WB = ws + WS_W;
            if (step == 0 && layer > 0) {
                continue;
            } else if (step == 0) {
                CVT_WEIGHTS(layer, true, true);
                if (layer == 0) {
                    const int* pos = (const int*)INP(2);
                    for (int idx = bx * 512 + tid; idx < MTOK * 32; idx += G * 512) {
                        const int m = idx >> 5, i = idx & 31;
                        const float ang = (float)pos[m] * INV_FREQ[i];
                        double rev = (double)ang * 0.15915494309189535; rev -= __builtin_rint(rev);
                        const float rr = (float)(rev * 6.283185307179586);
                        cosT[idx] = __cosf(rr); sinT[idx] = __sinf(rr);
                    }
                    const float* x = INP(0);
                    for (int m = gw; m < MTOK; m += NGW) x_row(x + (size_t)m * DM, HB2 + (size_t)m * DM, SSQ + (size_t)m * 16, lane);
                }
            } else if (step == 4) {
                continue;
            } else if (step == 6) {
                for (int i = 0; i < 1024; ++i) {
                    const int idx = i * G + vcu; if (idx >= 1024) break;
                    const int c = idx & 255, rnd = idx >> 8, bh = c >> 2, s = c & 3;
                    const int qb = (rnd == 0) ? 15 - s : (rnd == 1) ? 11 - s : (rnd == 2) ? 4 + s : s;
                    att::attn_unit(bh >> 3, bh & 7, qb, QNP, QRP, KNOPE, KROPE, VB, ATT, (char*)lds);
                }
            } else {
                const bool side_first = (bx & 1) == 0;
#pragma unroll 1
                for (int part = 0; part < 2; ++part) {
                int tidp_ = threadIdx.x; asm volatile("" : "+v"(tidp_)); const int tid = tidp_, lane = tid & 63, wave = __builtin_amdgcn_readfirstlane(tid >> 6), gw = bx * NWAVES + wave;
                if ((part == 0) == side_first) {
                if (step == 11 && layer + 1 < DEPTH) { CVT_WEIGHTS(layer + 1, false, true); __syncthreads(); }
                if (step == 1 && layer > 0) { CVT_WEIGHTS(layer, true, false); __syncthreads(); }
                if (step == 5) {
                const float* cw = INP(8) + layer * 3 * 512;
                const int c0 = lane * 8;
                f32x4 w0a = *(const f32x4*)(cw + c0), w0b = *(const f32x4*)(cw + c0 + 4), w1a = *(const f32x4*)(cw + 512 + c0), w1b = *(const f32x4*)(cw + 512 + c0 + 4),
                      w2a = *(const f32x4*)(cw + 1024 + c0), w2b = *(const f32x4*)(cw + 1024 + c0 + 4);
#pragma unroll 4
                for (int m = gw; m < MTOK; m += NGW) {
                    const int t = m & (SEQ - 1);
                    const bf16* cr = CONV + (size_t)m * 1536;
                    f32x4 ya, yb;
                    { f32x4 ca, cb, va, vb; pg8::unpack8(*(const v4u*)(cr + 512 + c0), ca, cb); pg8::unpack8(*(const v4u*)(cr + 1024 + c0), va, vb); ya = w2a * (ca * va); yb = w2b * (cb * vb); }
                    if (t >= 1) { f32x4 ca, cb, va, vb; pg8::unpack8(*(const v4u*)(cr - 1536 + 512 + c0), ca, cb); pg8::unpack8(*(const v4u*)(cr - 1536 + 1024 + c0), va, vb); ya += w1a * (ca * va); yb += w1b * (cb * vb); }
                    if (t >= 2) { f32x4 ca, cb, va, vb; pg8::unpack8(*(const v4u*)(cr - 3072 + 512 + c0), ca, cb); pg8::unpack8(*(const v4u*)(cr - 3072 + 1024 + c0), va, vb); ya += w0a * (ca * va); yb += w0b * (cb * vb); }
                    { f32x4 ba, bb; pg8::unpack8(*(const v4u*)(cr + c0), ba, bb); *(v4u*)(YCB + (size_t)m * 512 + c0) = pg8::pack8(ba * ya, bb * yb); }
                    const bf16* lr = LORA + (size_t)m * 768;
                    if (lane < 32) { const float x1 = pg8::bf_lo((unsigned)lr[640 + lane]), x2 = pg8::bf_lo((unsigned)lr[672 + lane]);
                      const float c = cosT[(size_t)m * 32 + lane], s = sinT[(size_t)m * 32 + lane];
                      KROPE[(size_t)m * 64 + lane] = (bf16)(pk2(x1 * c - x2 * s, 0.f) & 0xffffu); KROPE[(size_t)m * 64 + 32 + lane] = (bf16)(pk2(x2 * c + x1 * s, 0.f) & 0xffffu); }
                }
                }
                if (step == 8) {
                    const float* p = INP(1) + (size_t)layer * MTOK * 256;
                    for (int idx = bx * 512 + tid; idx < MTOK * 256 / 8; idx += G * 512) {
                        const f32x4 x0 = *(const f32x4*)(p + (size_t)idx * 8), x1 = *(const f32x4*)(p + (size_t)idx * 8 + 4);
                        v4u o; o.x = pk2(x0.x, x0.y); o.y = pk2(x0.z, x0.w); o.z = pk2(x1.x, x1.y); o.w = pk2(x1.z, x1.w);
                        *(v4u*)(PB + (size_t)idx * 8) = o;
                    }
                }
                __syncthreads();
                } else {
                const int ng = (step == 5 || step == 7 || step == 9) ? 2 : 1;
                constexpr size_t SQA = (size_t)MTOK * 16; float* sq0 = SSQ + (size_t)(layer * 4) * SQA;
                for (int gi = 0; gi < ng; ++gi) {
                    pg8::Gemm g; g.M = MTOK; g.lda = 0; pg8::Epi E{}; int sq_off = 0, sq_n4 = 4, sq_stride = 16; float sq_inv = 1.f / DM; E.h = h; E.cosT = cosT; E.sinT = sinT; E.scale = 1.f; E.hb = HB; E.rl = (LAS float*)((LAS unsigned char*)lds + RING_BYTES + 1024);
                    if (step == 1) { g.A = HB2; g.Bt = (const bf16*)(WB + WO_GU1); g.N = 5632; g.K = 1024; E.mode = pg8::EPI_GU; E.o0 = HID; E.ssq_in = sq0; }
                    else if (step == 9 && gi == 0) { g.A = HB; g.Bt = (const bf16*)(WB + WO_GU2); g.N = 5632; g.K = 1024; E.mode = pg8::EPI_GU; E.o0 = HID; E.ssq_in = sq0 + 2 * SQA; }
                    else if (step == 2 || step == 10) { g.A = HID; g.Bt = (const bf16*)(WB + (step == 2 ? WO_DN1 : WO_DN2)); g.N = 1024; g.K = 2816; E.mode = pg8::EPI_RES; E.ssq_out = sq0 + (step == 2 ? 1 : 3) * SQA; E.hsrc = (step == 2) ? HB2 : HB; }
                    else if (step == 3) { g.A = HB; g.Bt = (const bf16*)(WB + WO_IN); g.N = 4352; g.K = 1024; E.mode = pg8::EPI_SPLIT; E.o0 = CONV; E.ld0 = 1536; E.t1 = 6; E.o1 = GATES; E.ld1 = 2048; E.t2 = 14; E.sig1 = 1; E.o2 = LORA; E.ld2 = 768; E.ssq_in = sq0 + SQA; E.lssq = LSSQ; }
                    else if (step == 5 && gi == 0) { g.A = LORA; g.lda = 768; g.Bt = (const bf16*)(WB + WO_UQ); g.N = 1536; g.K = 384; E.mode = pg8::EPI_UQ; E.o0 = QNP; E.o1 = QRP; E.ssq_in = LSSQ; sq_off = 0; sq_n4 = 3; sq_stride = 32; sq_inv = 1.f / 384.f; }
                    else if (step == 5) { g.A = LORA + 384; g.lda = 768; E.ssq_in = LSSQ; sq_off = 12; sq_n4 = 2; sq_stride = 32; sq_inv = 1.f / 256.f; g.Bt = (const bf16*)(WB + WO_UKV); g.N = 2048; g.K = 256; E.mode = pg8::EPI_SPLIT; E.o0 = KNOPE; E.ld0 = 1024; E.t1 = 4; E.o1 = VB; E.ld1 = 1024; E.t2 = 1000; E.o2 = VB; E.ld2 = 1024; }
                    else if (step == 7 && gi == 0) { g.A = ATT; g.Bt = (const bf16*)(WB + WO_MO); g.N = 1024; g.K = 1024; E.mode = pg8::EPI_MO; E.o0 = XN; E.g = GATES; }
                    else if (step == 7) { g.A = YCB; g.Bt = (const bf16*)(WB + WO_CO); g.N = 1024; g.K = 512; E.mode = pg8::EPI_CO; E.o0 = XN; E.g = GATES; }
                    else if (step == 8) { g.A = XN; g.Bt = (const bf16*)(WB + WO_WO); g.N = 1024; g.K = 1024; E.mode = pg8::EPI_RES; E.scale = 1.f; E.ssq_out = sq0 + 2 * SQA; E.hsrc = HB; }
                    else if (step == 9) { g.A = PB; g.Bt = (const bf16*)(WB + WO_PP); g.N = 1024; g.K = 256; E.mode = pg8::EPI_SPLIT; E.o0 = PP; E.ld0 = 1024; E.t1 = 1000; E.t2 = 1000; E.o1 = PP; E.o2 = PP; E.ld1 = 1024; E.ld2 = 1024; }
                    else { g.A = HB; g.Bt = (const bf16*)(WB + WO_PG); g.N = 1024; g.K = 1024; E.mode = pg8::EPI_PLE; E.g = PP; E.ssq_in = sq0 + 3 * SQA; E.ssq_out = sq0 + 4 * SQA; E.hb2 = HB2; }
                    pg8::StaticOrder S; S.init(g.M, g.N, G, bx);
                    if (g.lda == 0) g.lda = g.K;
                    if (E.ssq_in) {
                        pg8::Unit uu;
                        for (int i = 0; S.next(i, uu); ++i)
                            if (tid < 256) { const f32x4* sp = (const f32x4*)(E.ssq_in + (size_t)(uu.pm * 256 + tid) * sq_stride + sq_off); f32x4 s4 = sp[0];
                                for (int q4 = 1; q4 < sq_n4; ++q4) s4 += sp[q4];
                                E.rl[i * 256 + tid] = 1.0f / sqrtf(((s4[0] + s4[1]) + (s4[2] + s4[3])) * sq_inv + EPS); }
                        __syncthreads();
                    }
                    pg8::gemm_phase<pg8::Epi, pg8::StaticOrder, true, true>((LAS unsigned char*)lds, g, S, E);
                }
                __syncthreads();
                }
                }
            }
            if (a.ws == nullptr) grid.sync();     xcd_barrier(bar);
        }
    }
    { const float* gain = INP(22); const int tid = threadIdx.x, lane = tid & 63, wave = __builtin_amdgcn_readfirstlane(tid >> 6), gw = bx * NWAVES + wave;
      const bf16* HB2 = (const bf16*)(a.ws + WS_XN);
      for (int m = gw; m < MTOK; m += NGW) {
          const v4u* xr = (const v4u*)(HB2 + (size_t)m * DM) + lane * 2; f32x4 v[4];
          pg8::unpack8(xr[0], v[0], v[1]); pg8::unpack8(xr[1], v[2], v[3]);
          float s = 0.f;
#pragma unroll
          for (int j = 0; j < 4; ++j) s += (v[j].x * v[j].x + v[j].y * v[j].y) + (v[j].z * v[j].z + v[j].w * v[j].w);
          const float r = 1.0f / sqrtf(wave_sum(s) * (1.f / DM) + EPS);
          const f32x4* gr = (const f32x4*)gain + lane * 4; f32x4* orow = (f32x4*)(h + (size_t)m * DM) + lane * 4;
#pragma unroll
          for (int j = 0; j < 4; ++j) orow[j] = v[j] * r * gr[j];
      } }
}

extern "C" void kernel_launch(void* const* d_in, const int* in_sizes, int n_in, void* d_out, int out_size, void* d_ws, size_t ws_size, hipStream_t stream) {
    static int grid = 0;
    if (grid == 0) {
        if (n_in != 23 || out_size != MTOK * DM || ws_size < WS_END) { fprintf(stderr, "kernel_launch: unexpected shapes: n_in %d out %d ws %zu (need %zu)\n", n_in, out_size, ws_size, (size_t)WS_END); grid = -1; return; }
        int dev = 0, cus = 0, per_cu = 0;
        if (hipGetDevice(&dev) != hipSuccess || hipDeviceGetAttribute(&cus, hipDeviceAttributeMultiprocessorCount, dev) != hipSuccess) { grid = -1; return; }
        if (hipFuncSetAttribute((const void*)mega_fwd, hipFuncAttributeMaxDynamicSharedMemorySize, LDS_BYTES) != hipSuccess) { fprintf(stderr, "kernel_launch: hipFuncSetAttribute failed\n"); grid = -1; return; }
        if (hipOccupancyMaxActiveBlocksPerMultiprocessor(&per_cu, (const void*)mega_fwd, NWAVES * 64, LDS_BYTES) != hipSuccess || per_cu < 1) { fprintf(stderr, "kernel_launch: occupancy query says %d\n", per_cu); per_cu = 1; }
        (void)hipGetLastError();
        grid = cus * per_cu;
    }
    if (grid < 0) return;
    if (hipMemsetAsync((char*)d_ws + WS_CTL, 0, CTL_ZERO_BYTES, stream) != hipSuccess) { fprintf(stderr, "kernel_launch: memset failed\n"); return; }
    Args a{};
    for (int i = 0; i < 23; ++i) a.in[i] = (const float*)d_in[i];
    a.out = (float*)d_out; a.ws = (unsigned char*)d_ws;
    void* args[] = {&a};
    hipError_t e = hipLaunchCooperativeKernel((const void*)mega_fwd, dim3(grid), dim3(NWAVES * 64), args, LDS_BYTES, stream);
    if (e != hipSuccess) fprintf(stderr, "cooperative launch failed: %s (grid %d)\n", hipGetErrorString(e), grid);
}
```

```cpp
#include <hip/hip_runtime.h>
#include <hip/hip_cooperative_groups.h>
#include <cstdio>
#include <cstdint>
namespace cg = cooperative_groups;

constexpr int MTOK = 32768, DM = 1024, DFF = 2816, SEQ = 4096, DEPTH = 4;
constexpr float EPS = 1e-6f;
__constant__ float INV_FREQ[32] = {
 0x1.0000000000000p+0f, 0x1.7ff2220000000p-1f, 0x1.1feb340000000p-1f, 0x1.afd1360000000p-2f, 0x1.43d1360000000p-2f, 0x1.e5a8480000000p-3f, 0x1.6c310e0000000p-3f, 0x1.111aee0000000p-3f,
 0x1.99999a0000000p-4f, 0x1.33281c0000000p-4f, 0x1.ccab860000000p-5f, 0x1.59742a0000000p-5f, 0x1.030dc40000000p-5f, 0x1.8486a00000000p-6f, 0x1.235a720000000p-6f, 0x1.b4f7e20000000p-7f,
 0x1.47ae140000000p-7f, 0x1.eb73600000000p-8f, 0x1.7089380000000p-8f, 0x1.145cee0000000p-8f, 0x1.9e7c6e0000000p-9f, 0x1.36d21a0000000p-9f, 0x1.d22a500000000p-10f, 0x1.5d931c0000000p-10f,
 0x1.0624de0000000p-10f, 0x1.8929180000000p-11f, 0x1.26d42c0000000p-11f, 0x1.ba2e4c0000000p-12f, 0x1.4b96be0000000p-12f, 0x1.f150280000000p-13f, 0x1.74eea60000000p-13f, 0x1.17a8e40000000p-13f};

namespace pg8 {
#define PG8_LAS __attribute__((address_space(3)))
typedef unsigned short bf16_t;
typedef short bf16x8 __attribute__((ext_vector_type(8)));
typedef float f32x4 __attribute__((ext_vector_type(4)));
typedef unsigned u32x4 __attribute__((ext_vector_type(4)));
constexpr int BM = 256, BK = 64, HALF = 128, HTB = HALF * BK * 2  , STAGE_BYTES = 8 * HTB, NXCD = 8, WGM = 8;

__host__ __device__ __forceinline__ int lds_byte(int r, int c) { const int st = (r >> 4) * 2 + (c >> 5), rr = r & 15, cc = c & 31, ob = rr * 64 + cc * 2; return st * 1024 + (ob ^ (((ob >> 9) & 1) << 5)); }
__host__ __device__ __forceinline__ void stage_rc(int b, int& R, int& C) { const int st = b / 1024, sb = b % 1024, swz = sb ^ (((sb >> 9) & 1) << 5); R = (st >> 1) * 16 + swz / 64; C = (st & 1) * 32 + (swz % 64) / 2; }
__host__ __device__ __forceinline__ int perm32(int rho) { const int n = rho >> 4, i = rho & 15; return 8 * (i >> 2) + 4 * n + (i & 3); }

struct Unit { int pm, pn; };
struct Gemm { const bf16_t* A; const bf16_t* Bt; int M, N, K, lda; };

struct StaticOrder {
    int nM, nN, nwg, G, c;
    __host__ __device__ void init(int M, int N, int G_, int c_) { nM = M / BM; nN = N / BM; nwg = nM * nN; G = G_; c = c_; }
    __host__ __device__ bool next(int i, Unit& u) const {
        const long L = (long)i * G + c; if (L >= nwg) return false;
        int wgid = (int)L; { const int q = nwg / NXCD, r = nwg % NXCD, xcd = wgid % NXCD, off = wgid / NXCD; wgid = (xcd < r ? xcd * (q + 1) : r * (q + 1) + (xcd - r) * q) + off; }
        const int nig = WGM * nN, gid = wgid / nig, fm = gid * WGM, gsz = (nM - fm) < WGM ? (nM - fm) : WGM;
        u.pm = fm + ((wgid % nig) % gsz); u.pn = (wgid % nig) / gsz; return true;
    }
    __device__ __forceinline__ void a_ready(const Unit&) const {}
    __device__ __forceinline__ void done(const Unit&) const {}
};

typedef unsigned u32x2 __attribute__((ext_vector_type(2)));
typedef _Float16 h16x8 __attribute__((ext_vector_type(8)));
__device__ __forceinline__ unsigned cvt_pk_bf16(float lo, float hi) { unsigned r; asm volatile("v_cvt_pk_bf16_f32 %0, %1, %2" : "=v"(r) : "v"(lo), "v"(hi)); return r; }
__device__ __forceinline__ float sigm(float x) { return __builtin_amdgcn_rcpf(1.f + __builtin_amdgcn_exp2f(-1.4426950408889634f * x)); }
__device__ __forceinline__ float bf_lo(unsigned w) { return __builtin_bit_cast(float, w << 16); }
__device__ __forceinline__ float bf_hi(unsigned w) { return __builtin_bit_cast(float, w & 0xffff0000u); }
__device__ __forceinline__ u32x4 pack8(const f32x4& a, const f32x4& b) { u32x4 w; w.x = cvt_pk_bf16(a[0], a[1]); w.y = cvt_pk_bf16(a[2], a[3]); w.z = cvt_pk_bf16(b[0], b[1]); w.w = cvt_pk_bf16(b[2], b[3]); return w; }
__device__ __forceinline__ void unpack8(const u32x4& w, f32x4& a, f32x4& b) { a[0] = bf_lo(w.x); a[1] = bf_hi(w.x); a[2] = bf_lo(w.y); a[3] = bf_hi(w.y); b[0] = bf_lo(w.z); b[1] = bf_hi(w.z); b[2] = bf_lo(w.w); b[3] = bf_hi(w.w); }

enum { EPI_GU = 0, EPI_RES = 1, EPI_SPLIT = 2, EPI_UQ = 3, EPI_MO = 4, EPI_CO = 5, EPI_PLE = 6 };
struct Epi {
    int mode; float scale;
    float* h;
    bf16_t* o0; bf16_t* o1; bf16_t* o2; int ld0, ld1, ld2, t1, t2, sig1;
    const bf16_t* g;
    const float* cosT; const float* sinT;
    const float* ssq_in; float* ssq_out; bf16_t* hb; bf16_t* hb2; const bf16_t* hsrc; float* lssq; PG8_LAS float* rl;
    mutable int ui;
    __device__ __forceinline__ void init_acc(f32x4 (&acc)[2][2][4][2], const Unit& u, int wr, int wc, int fr, int fq) const {
        if (mode == EPI_RES) {
            const bf16_t* base = hsrc + (size_t)(u.pm * BM + wr * 64 + fr) * DM + u.pn * BM + wc * 32 + 8 * fq;
            u32x4 t[2][4][2];
#pragma unroll
            for (int ai = 0; ai < 2; ++ai)
#pragma unroll
                for (int m = 0; m < 4; ++m)
#pragma unroll
                    for (int bj = 0; bj < 2; ++bj) t[ai][m][bj] = *(const u32x4*)(base + (size_t)(ai * HALF + m * 16) * DM + bj * HALF);
#pragma unroll
            for (int ai = 0; ai < 2; ++ai)
#pragma unroll
                for (int m = 0; m < 4; ++m)
#pragma unroll
                    for (int bj = 0; bj < 2; ++bj) unpack8(t[ai][m][bj], acc[ai][bj][m][0], acc[ai][bj][m][1]);
        } else {
#pragma unroll
            for (int ai = 0; ai < 2; ++ai)
#pragma unroll
                for (int bj = 0; bj < 2; ++bj)
#pragma unroll
                    for (int m = 0; m < 4; ++m) { acc[ai][bj][m][0] = (f32x4){0.f, 0.f, 0.f, 0.f}; acc[ai][bj][m][1] = (f32x4){0.f, 0.f, 0.f, 0.f}; }
        }
    }
    __device__ __forceinline__ void operator()(f32x4 (&acc)[2][2][4][2], const Unit& u, int wr, int wc, int fr, int fq) const {
        const int row0 = u.pm * BM + wr * 64 + fr;
        float rs[2][4];
        if (ssq_in) {
#pragma unroll
            for (int ai = 0; ai < 2; ++ai)
#pragma unroll
                for (int m = 0; m < 4; ++m) rs[ai][m] = rl[ui * BM + wr * 64 + ai * HALF + m * 16 + fr];
        } else {
#pragma unroll
            for (int ai = 0; ai < 2; ++ai)
#pragma unroll
                for (int m = 0; m < 4; ++m) rs[ai][m] = 1.f;
        }
        ++ui;
        if (mode == EPI_GU) {
            const int col = u.pn * 128 + wc * 32 + 8 * fq;
#pragma unroll
            for (int ai = 0; ai < 2; ++ai)
#pragma unroll
                for (int m = 0; m < 4; ++m) { f32x4 r0, r1;
#pragma unroll
                    for (int j = 0; j < 4; ++j) { const float g0 = acc[ai][0][m][0][j] * rs[ai][m], g1 = acc[ai][0][m][1][j] * rs[ai][m]; r0[j] = g0 * sigm(g0) * (acc[ai][1][m][0][j] * rs[ai][m]); r1[j] = g1 * sigm(g1) * (acc[ai][1][m][1][j] * rs[ai][m]); }
                    *(u32x4*)(o0 + (size_t)(row0 + ai * HALF + m * 16) * DFF + col) = pack8(r0, r1); }
        } else if (mode == EPI_RES) {
#pragma unroll
            for (int ai = 0; ai < 2; ++ai)
#pragma unroll
                for (int m = 0; m < 4; ++m) { const size_t row = (size_t)(row0 + ai * HALF + m * 16); const int col = u.pn * BM + wc * 32 + 8 * fq; float sq = 0.f;
#pragma unroll
                    for (int bj = 0; bj < 2; ++bj) { const f32x4 a = acc[ai][bj][m][0], b = acc[ai][bj][m][1];
                        *(u32x4*)(hb + row * DM + col + bj * HALF) = pack8(a, b);
                        sq += (a[0] * a[0] + a[1] * a[1]) + (a[2] * a[2] + a[3] * a[3]) + (b[0] * b[0] + b[1] * b[1]) + (b[2] * b[2] + b[3] * b[3]); }
                    sq += __shfl_xor(sq, 16); sq += __shfl_xor(sq, 32);
                    if (fq == 0) ssq_out[row * 16 + u.pn * 4 + wc] = sq;
                    }
        } else if (mode == EPI_SPLIT) {
            bf16_t* base; int ld, colt; bool sg = false;
            if (u.pn < t1) { base = o0; ld = ld0; colt = u.pn * BM; } else if (u.pn < t2) { base = o1; ld = ld1; colt = (u.pn - t1) * BM; sg = sig1 != 0; } else { base = o2; ld = ld2; colt = (u.pn - t2) * BM; }
#pragma unroll
            for (int ai = 0; ai < 2; ++ai)
#pragma unroll
                for (int m = 0; m < 4; ++m) { bf16_t* rowp = base + (size_t)(row0 + ai * HALF + m * 16) * ld + colt + wc * 32 + 8 * fq;
#pragma unroll
                    for (int bj = 0; bj < 2; ++bj) { f32x4 a = acc[ai][bj][m][0] * rs[ai][m], b = acc[ai][bj][m][1] * rs[ai][m];
                        if (sg) {
#pragma unroll
                            for (int j = 0; j < 4; ++j) { a[j] = sigm(a[j]); b[j] = sigm(b[j]); } }
                        *(u32x4*)(rowp + bj * HALF) = pack8(a, b);
                        if (lssq && u.pn >= t2) {
                            float sq = (a[0] * a[0] + a[1] * a[1]) + (a[2] * a[2] + a[3] * a[3]) + (b[0] * b[0] + b[1] * b[1]) + (b[2] * b[2] + b[3] * b[3]);
                            sq += __shfl_xor(sq, 16); sq += __shfl_xor(sq, 32);
                            if (fq == 0) lssq[(size_t)(row0 + ai * HALF + m * 16) * 32 + (u.pn - t2) * 8 + bj * 4 + wc] = sq; } } }
        } else if (mode == EPI_UQ) {
            if (u.pn < 4) {
#pragma unroll
                for (int ai = 0; ai < 2; ++ai)
#pragma unroll
                    for (int m = 0; m < 4; ++m) { bf16_t* rowp = o0 + (size_t)(row0 + ai * HALF + m * 16) * 1024 + u.pn * BM + wc * 32 + 8 * fq;
#pragma unroll
                        for (int bj = 0; bj < 2; ++bj) *(u32x4*)(rowp + bj * HALF) = pack8(acc[ai][bj][m][0] * rs[ai][m], acc[ai][bj][m][1] * rs[ai][m]); }
            } else {
                const int i0 = (wc & 1) * 16 + 4 * fq;
#pragma unroll
                for (int ai = 0; ai < 2; ++ai)
#pragma unroll
                    for (int m = 0; m < 4; ++m) { const int row = row0 + ai * HALF + m * 16;
                        const f32x4 cs = *(const f32x4*)(cosT + (size_t)row * 32 + i0), sn = *(const f32x4*)(sinT + (size_t)row * 32 + i0);
#pragma unroll
                        for (int bj = 0; bj < 2; ++bj) { const int head = (u.pn - 4) * 4 + 2 * bj + (wc >> 1);
                            const f32x4 x1 = acc[ai][bj][m][0] * rs[ai][m], x2 = acc[ai][bj][m][1] * rs[ai][m]; const f32x4 y1 = x1 * cs - x2 * sn, y2 = x2 * cs + x1 * sn;
                            bf16_t* p = o1 + (size_t)row * 512 + head * 64 + i0;
                            u32x2 w1, w2; w1.x = cvt_pk_bf16(y1[0], y1[1]); w1.y = cvt_pk_bf16(y1[2], y1[3]); w2.x = cvt_pk_bf16(y2[0], y2[1]); w2.y = cvt_pk_bf16(y2[2], y2[3]);
                            *(u32x2*)p = w1; *(u32x2*)(p + 32) = w2; } }
            }
        } else if (mode == EPI_MO || mode == EPI_CO) {
            const int goff = (mode == EPI_MO) ? 1024 : 0;
#pragma unroll
            for (int ai = 0; ai < 2; ++ai)
#pragma unroll
                for (int m = 0; m < 4; ++m) { const size_t row = (size_t)(row0 + ai * HALF + m * 16); const int col = u.pn * BM + wc * 32 + 8 * fq;
#pragma unroll
                    for (int bj = 0; bj < 2; ++bj) { f32x4 ga, gb; unpack8(*(const u32x4*)(g + row * 2048 + goff + col + bj * HALF), ga, gb);
                        f32x4 a = ga * acc[ai][bj][m][0], b = gb * acc[ai][bj][m][1];
                        bf16_t* p = o0 + row * DM + col + bj * HALF;
                        if (mode == EPI_CO) { f32x4 pa, pb; unpack8(*(const u32x4*)p, pa, pb); a += pa; b += pb; }
                        *(u32x4*)p = pack8(a, b); } }
        } else {
#pragma unroll
            for (int ai = 0; ai < 2; ++ai)
#pragma unroll
                for (int m = 0; m < 4; ++m) { const size_t row = (size_t)(row0 + ai * HALF + m * 16); const int col = u.pn * BM + wc * 32 + 8 * fq; float sq = 0.f;
#pragma unroll
                    for (int bj = 0; bj < 2; ++bj) { f32x4 pa, pb, a, b; unpack8(*(const u32x4*)(g + row * DM + col + bj * HALF), pa, pb); unpack8(*(const u32x4*)(hb + row * DM + col + bj * HALF), a, b);
#pragma unroll
                        for (int j = 0; j < 4; ++j) { a[j] += sigm(acc[ai][bj][m][0][j] * rs[ai][m]) * pa[j]; b[j] += sigm(acc[ai][bj][m][1][j] * rs[ai][m]) * pb[j]; }
                        *(u32x4*)(hb2 + row * DM + col + bj * HALF) = pack8(a, b);
                        sq += (a[0] * a[0] + a[1] * a[1]) + (a[2] * a[2] + a[3] * a[3]) + (b[0] * b[0] + b[1] * b[1]) + (b[2] * b[2] + b[3] * b[3]); }
                    sq += __shfl_xor(sq, 16); sq += __shfl_xor(sq, 32);
                    if (fq == 0) ssq_out[row * 16 + u.pn * 4 + wc] = sq;
                    }
        }
    }
};
template <class Epi, class Sched, bool ALIGN_EPI = false, bool SP2 = false>
__device__ __forceinline__ void gemm_phase(PG8_LAS unsigned char* lds, const Gemm g, const Sched& S, const Epi& E) {
    int tid_ = threadIdx.x; asm volatile("" : "+v"(tid_)); const int tid = tid_, wid = __builtin_amdgcn_readfirstlane(tid >> 6), lane = tid & 63, wr = wid >> 2, wc = wid & 3, fr = lane & 15, fq = lane >> 4;
    const int K = g.K, nt = K / BK;
    unsigned voffA[2], voffB[2];
#pragma unroll
    for (int i = 0; i < 2; ++i) { int R, C; stage_rc(tid * 16 + i * 8192, R, C); const int Rb = true ? ((R & ~31) + perm32(R & 31)) : R;
        voffA[i] = (unsigned)(R * g.lda + C) * 2u; voffB[i] = (unsigned)(Rb * K + C) * 2u; }
    const size_t kstep = (size_t)(BK * 2);
    const size_t hstepA = (size_t)HALF * g.lda * 2, hstep = (size_t)HALF * K * 2;
    const size_t tstepA = 2 * hstepA, tstep = 2 * hstep;
    const unsigned ldsw = (unsigned)wid * 1024u;
    const int aoff = lds_byte(wr * 64 + fr, fq * 8), boff = lds_byte(wc * 32 + fr, fq * 8);
#define PG8_SA(b, h) (((b) * 2 + (h)) * HTB)
#define PG8_SB(b, h) ((4 + (b) * 2 + (h)) * HTB)
#define PG8_STAGE(bufoff, gbase, voff) do { _Pragma("unroll") for (int _i = 0; _i < 2; ++_i) \
        __builtin_amdgcn_global_load_lds((const unsigned*)((const char*)(gbase) + (voff)[_i]), (PG8_LAS unsigned*)(lds + (bufoff) + ldsw + _i * 8192), 16, 0, 0); } while (0)
#define PG8_LDA(dst, b, h) do { _Pragma("unroll") for (int m = 0; m < 4; ++m) _Pragma("unroll") for (int k = 0; k < 2; ++k) dst[m][k] = *(const PG8_LAS bf16x8*)(lds + PG8_SA(b, h) + aoff + m * 2048 + k * 1024); } while (0)
#define PG8_LDB(dst, b, h) do { _Pragma("unroll") for (int n = 0; n < 2; ++n) _Pragma("unroll") for (int k = 0; k < 2; ++k) dst[n][k] = *(const PG8_LAS bf16x8*)(lds + PG8_SB(b, h) + boff + n * 2048 + k * 1024); } while (0)
#define PG8_MMA(ai, bj, At, Bt) do { __builtin_amdgcn_s_setprio(1); _Pragma("unroll") for (int m = 0; m < 4; ++m) _Pragma("unroll") for (int n = 0; n < 2; ++n) _Pragma("unroll") for (int k = 0; k < 2; ++k) \
        acc[ai][bj][m][n] = __builtin_amdgcn_mfma_f32_16x16x32_bf16(Bt[n][k], At[m][k], acc[ai][bj][m][n], 0, 0, 0); __builtin_amdgcn_s_setprio(0); } while (0)
#define PG8_WAIT_V(n) asm volatile("s_waitcnt vmcnt(" #n ")" ::: "memory")
#define PG8_WAIT_L(n) asm volatile("s_waitcnt lgkmcnt(" #n ")" ::: "memory")
#define PG8_BAR __builtin_amdgcn_s_barrier()
#define PG8_SCHED __builtin_amdgcn_sched_barrier(0)
    Unit cur, nxt; int ui = 0;
    if (!S.next(0, cur)) return;
    f32x4 acc[2][2][4][2];
    E.init_acc(acc, cur, wr, wc, fr, fq);
    bf16x8 At[4][2], B0[2][2], B1[2][2];
    const char* cA = (const char*)g.A + (size_t)cur.pm * tstepA; const char* cB = (const char*)g.Bt + (size_t)cur.pn * tstep;
    S.a_ready(cur);
    if constexpr (SP2) {
        PG8_STAGE(PG8_SB(0, 0), cB, voffB); PG8_STAGE(PG8_SB(0, 1), cB + hstep, voffB); PG8_STAGE(PG8_SA(0, 0), cA, voffA); PG8_STAGE(PG8_SA(0, 1), cA + hstepA, voffA);
        if (wr == 1) PG8_BAR;
        PG8_WAIT_V(2); PG8_BAR;
        PG8_STAGE(PG8_SB(1, 0), cB + kstep, voffB); PG8_STAGE(PG8_SA(1, 0), cA + kstep, voffA); PG8_STAGE(PG8_SB(1, 1), cB + hstep + kstep, voffB);
        PG8_WAIT_V(6); PG8_BAR;
    } else {
        PG8_STAGE(PG8_SB(0, 0), cB, voffB); PG8_STAGE(PG8_SA(0, 0), cA, voffA); PG8_STAGE(PG8_SB(0, 1), cB + hstep, voffB); PG8_STAGE(PG8_SA(0, 1), cA + hstepA, voffA);
        if (wr == 1) PG8_BAR;
        PG8_WAIT_V(4); PG8_BAR;
        PG8_STAGE(PG8_SB(1, 0), cB + kstep, voffB); PG8_STAGE(PG8_SA(1, 0), cA + kstep, voffA); PG8_STAGE(PG8_SB(1, 1), cB + hstep + kstep, voffB);
        PG8_WAIT_V(6); PG8_BAR;
    }
    for (;;) {
        const bool has_next = S.next(ui + 1, nxt);
        const char* nA = has_next ? (const char*)g.A + (size_t)nxt.pm * tstepA : cA; const char* nB = has_next ? (const char*)g.Bt + (size_t)nxt.pn * tstep : cB;
        for (int t = 0; t < nt; t += 2) {
            const bool last = (t == nt - 2);
            const char* a1 = cA + (size_t)(t + 1) * kstep;
            const char* a2 = last ? nA : cA + (size_t)(t + 2) * kstep; const char* b2 = last ? nB : cB + (size_t)(t + 2) * kstep;
            const char* a3 = a2 + kstep; const char* b3 = b2 + kstep;
            if (last && has_next) S.a_ready(nxt);
            if constexpr (SP2) {
            PG8_LDB(B0, 0, 0); PG8_LDB(B1, 0, 1); PG8_SCHED; PG8_LDA(At, 0, 0); PG8_STAGE(PG8_SA(1, 1), a1 + hstepA, voffA);
            PG8_WAIT_V(8); PG8_WAIT_L(0); PG8_BAR; PG8_MMA(0, 0, At, B0); PG8_MMA(0, 1, At, B1); PG8_BAR; PG8_SCHED;
            PG8_LDA(At, 0, 1); PG8_STAGE(PG8_SB(0, 0), b2, voffB); PG8_STAGE(PG8_SB(0, 1), b2 + hstep, voffB); PG8_STAGE(PG8_SA(0, 0), a2, voffA);
            PG8_WAIT_V(8); PG8_WAIT_L(0); PG8_BAR; PG8_MMA(1, 0, At, B0); PG8_MMA(1, 1, At, B1); PG8_BAR; PG8_SCHED;
            PG8_LDB(B0, 1, 0); PG8_LDB(B1, 1, 1); PG8_SCHED; PG8_LDA(At, 1, 0); PG8_STAGE(PG8_SA(0, 1), a2 + hstepA, voffA);
            PG8_WAIT_V(8); PG8_WAIT_L(0); PG8_BAR; PG8_MMA(0, 0, At, B0); PG8_MMA(0, 1, At, B1); PG8_BAR; PG8_SCHED;
            PG8_LDA(At, 1, 1); PG8_STAGE(PG8_SB(1, 0), b3, voffB); PG8_STAGE(PG8_SB(1, 1), b3 + hstep, voffB); PG8_STAGE(PG8_SA(1, 0), a3, voffA);
            PG8_WAIT_V(8); PG8_WAIT_L(0); PG8_BAR; PG8_MMA(1, 0, At, B0); PG8_MMA(1, 1, At, B1); PG8_BAR; PG8_SCHED;
            } else {
            PG8_LDB(B0, 0, 0); PG8_SCHED; PG8_LDA(At, 0, 0); PG8_STAGE(PG8_SA(1, 1), a1 + hstepA, voffA);
            PG8_WAIT_L(8); PG8_BAR; PG8_WAIT_L(0); PG8_MMA(0, 0, At, B0); PG8_BAR; PG8_SCHED;
            PG8_LDB(B1, 0, 1); PG8_STAGE(PG8_SB(0, 0), b2, voffB);
            PG8_BAR; PG8_WAIT_L(0); PG8_MMA(0, 1, At, B1); PG8_BAR;
            PG8_LDA(At, 0, 1); PG8_STAGE(PG8_SA(0, 0), a2, voffA);
            PG8_BAR; PG8_WAIT_L(0); PG8_MMA(1, 0, At, B0); PG8_BAR; PG8_SCHED;
            PG8_STAGE(PG8_SB(0, 1), b2 + hstep, voffB);
            PG8_WAIT_V(6); PG8_BAR; PG8_MMA(1, 1, At, B1); PG8_BAR;
            PG8_LDB(B0, 1, 0); PG8_SCHED; PG8_LDA(At, 1, 0); PG8_STAGE(PG8_SA(0, 1), a2 + hstepA, voffA);
            PG8_WAIT_L(8); PG8_BAR; PG8_WAIT_L(0); PG8_MMA(0, 0, At, B0); PG8_BAR; PG8_SCHED;
            PG8_LDB(B1, 1, 1); PG8_STAGE(PG8_SB(1, 0), b3, voffB);
            PG8_BAR; PG8_WAIT_L(0); PG8_MMA(0, 1, At, B1); PG8_BAR;
            PG8_LDA(At, 1, 1); PG8_STAGE(PG8_SA(1, 0), a3, voffA);
            PG8_BAR; PG8_WAIT_L(0); PG8_MMA(1, 0, At, B0); PG8_BAR; PG8_SCHED;
            PG8_STAGE(PG8_SB(1, 1), b3 + hstep, voffB);
            PG8_WAIT_V(6); PG8_BAR; PG8_MMA(1, 1, At, B1); PG8_BAR;
            }
        }
        if constexpr (ALIGN_EPI) { if (wr == 0) PG8_BAR; }
        if constexpr (!false) { E(acc, cur, wr, wc, fr, fq); S.done(cur); }
        if (!has_next) break;
        E.init_acc(acc, nxt, wr, wc, fr, fq);
        cur = nxt; cA = nA; cB = nB; ++ui;
        if constexpr (ALIGN_EPI) { if (wr == 1) PG8_BAR; }
    }
    PG8_WAIT_V(0);
    if constexpr (!ALIGN_EPI) { if (wr == 0) PG8_BAR; }
    PG8_BAR;
    if constexpr (false) { E.fused(acc, cur, wr, wc, fr, fq, lds, wid, lane); S.done(cur); }
#undef PG8_SA
#undef PG8_SB
#undef PG8_STAGE
#undef PG8_LDA
#undef PG8_LDB
#undef PG8_MMA
#undef PG8_WAIT_V
#undef PG8_WAIT_L
#undef PG8_BAR
#undef PG8_SCHED
}
}
namespace att {
using bf16x8 = __attribute__((ext_vector_type(8))) short;
using s16x4  = __attribute__((ext_vector_type(4))) short;
using f32x16 = __attribute__((ext_vector_type(16))) float;
using u32x4  = __attribute__((ext_vector_type(4))) unsigned;
typedef unsigned short bf16_t;
constexpr int NW = 8, QBLK = 32, KVBLK = 64;
constexpr float SCALE = 0.07216878364870322f;
constexpr float THR = 8.f;
constexpr int SHM_V = 16384, SHM_KN = 16384, SHM_KR = 8192;
constexpr int OFF_V = 0, OFF_KN = 2 * SHM_V, OFF_KR = OFF_KN + 2 * SHM_KN, OFF_WS = OFF_KR + 2 * SHM_KR, LDS_BYTES = OFF_WS + NW * 64 * 4;
#define KSWZ(row, colB) ((row) * 256 + ((colB) ^ (((row) & 7) << 4)))
#define KRSWZ(row, colB) ((row) * 128 + ((colB) ^ ((((row) >> 1) & 7) << 4)))
#define SBAR() __builtin_amdgcn_sched_barrier(0)
__device__ __forceinline__ int crow(int r, int hi) { return (r & 3) + 8 * (r >> 2) + 4 * hi; }
__device__ __forceinline__ unsigned cvtpk(float lo, float hi) { unsigned r; asm volatile("v_cvt_pk_bf16_f32 %0, %1, %2" : "=v"(r) : "v"(lo), "v"(hi)); return r; }

__device__ __forceinline__ void partialSM(f32x16& p0, f32x16& p1, float& m_reg, float& mn, float& alpha) {
  constexpr float C = SCALE * 1.4426950408889634f;
  float pmax = p0[0];
#pragma unroll
  for (int r = 1; r < 16; ++r) pmax = fmaxf(pmax, p0[r]);
#pragma unroll
  for (int r = 0; r < 16; ++r) pmax = fmaxf(pmax, p1[r]);
  { auto rr = __builtin_amdgcn_permlane32_swap(__float_as_uint(pmax), __float_as_uint(pmax), false, false);
    pmax = fmaxf(__uint_as_float(rr[0]), __uint_as_float(rr[1])); }
  if (__builtin_expect(__all(pmax - m_reg <= THR / SCALE), 1)) { mn = m_reg; alpha = 1.f; }
  else { mn = fmaxf(m_reg, pmax); alpha = __builtin_amdgcn_exp2f((m_reg - mn) * C); m_reg = mn; }
  float mnC = -mn * C;
#pragma unroll
  for (int r = 0; r < 16; ++r) p0[r] = fmaf(p0[r], C, mnC);
#pragma unroll
  for (int r = 0; r < 16; ++r) p1[r] = fmaf(p1[r], C, mnC);
#pragma unroll
  for (int r = 0; r < 16; ++r) p0[r] = __builtin_amdgcn_exp2f(p0[r]);
}
__device__ __forceinline__ void finishSM(f32x16& p0, f32x16& p1, float alpha, float& l_reg, bf16x8& pa0, bf16x8& pa1, bf16x8& pa2, bf16x8& pa3) {
#pragma unroll
  for (int r = 0; r < 16; ++r) p1[r] = __builtin_amdgcn_exp2f(p1[r]);
  float ps = 0;
#pragma unroll
  for (int r = 0; r < 16; ++r) ps += p0[r];
#pragma unroll
  for (int r = 0; r < 16; ++r) ps += p1[r];
  { auto rr = __builtin_amdgcn_permlane32_swap(__float_as_uint(ps), __float_as_uint(ps), false, false);
    ps = __uint_as_float(rr[0]) + __uint_as_float(rr[1]); }
  l_reg = l_reg * alpha + ps;
#define PK4(P, BASE, OUT) do { unsigned a0 = cvtpk(P[BASE + 0], P[BASE + 1]), a1 = cvtpk(P[BASE + 2], P[BASE + 3]);   \
    unsigned b0 = cvtpk(P[BASE + 4], P[BASE + 5]), b1 = cvtpk(P[BASE + 6], P[BASE + 7]);                              \
    auto r0 = __builtin_amdgcn_permlane32_swap(a0, b0, false, false); auto r1 = __builtin_amdgcn_permlane32_swap(a1, b1, false, false); \
    u32x4 w = {r0[0], r1[0], r0[1], r1[1]}; OUT = *reinterpret_cast<bf16x8*>(&w); } while (0)
  PK4(p0, 0, pa0); PK4(p0, 8, pa1); PK4(p1, 0, pa2); PK4(p1, 8, pa3);
#undef PK4
}
__device__ __forceinline__ void qkt(f32x16& p0, f32x16& p1, const char* Kn, const char* Kr, const bf16x8* qr, int r32, int hi, bool live) {
  if (live) {
    p0 = f32x16{}; p1 = f32x16{};
#pragma unroll
    for (int d0 = 0; d0 < 8; ++d0) { const int cb = (d0 * 16 + hi * 8) * 2;
      bf16x8 b0 = *reinterpret_cast<const bf16x8*>(Kn + KSWZ(r32, cb));
      bf16x8 b1 = *reinterpret_cast<const bf16x8*>(Kn + KSWZ(32 + r32, cb));
      p0 = __builtin_amdgcn_mfma_f32_32x32x16_bf16(b0, qr[d0], p0, 0, 0, 0);
      p1 = __builtin_amdgcn_mfma_f32_32x32x16_bf16(b1, qr[d0], p1, 0, 0, 0); }
#pragma unroll
    for (int d0 = 0; d0 < 4; ++d0) { const int cb = (d0 * 16 + hi * 8) * 2;
      bf16x8 b0 = *reinterpret_cast<const bf16x8*>(Kr + KRSWZ(r32, cb));
      bf16x8 b1 = *reinterpret_cast<const bf16x8*>(Kr + KRSWZ(32 + r32, cb));
      p0 = __builtin_amdgcn_mfma_f32_32x32x16_bf16(b0, qr[8 + d0], p0, 0, 0, 0);
      p1 = __builtin_amdgcn_mfma_f32_32x32x16_bf16(b1, qr[8 + d0], p1, 0, 0, 0); }
  } else {
#pragma unroll
    for (int r = 0; r < 16; ++r) { p0[r] = -1e30f; p1[r] = -1e30f; }
  }
}
__device__ __forceinline__ int v_st(int k, int c) { const int kk = (k & ~0xC) | ((k & 4) << 1) | ((k & 8) >> 1); return ((kk >> 3) * 4 + (c >> 5)) * 512 + ((kk & 7) * 32 + (c & 31)) * 2; }
__device__ __forceinline__ int v_rd_base(int lane) { return ((lane & 3) << 3) | (((lane >> 2) & 3) << 6) | (((lane >> 4) & 1) << 5) | (((lane >> 5) & 1) << 8); }
constexpr int v_rd_off(int d0, int ks, int half) { return d0 * 512 + ks * 4096 + half * 2048; }
template <int OFF> __device__ __forceinline__ s16x4 tr_read(int vb) {
  s16x4 r; asm volatile("ds_read_b64_tr_b16 %0, %1 offset:%2" : "=&v"(r) : "v"(vb), "i"(OFF) : "memory"); return r;
}
template <int D0> __device__ __forceinline__ void pv_one(f32x16& od, int vb, bf16x8 pa0, bf16x8 pa1, bf16x8 pa2, bf16x8 pa3) {
  const s16x4 l0 = tr_read<v_rd_off(D0, 0, 0)>(vb), h0 = tr_read<v_rd_off(D0, 0, 1)>(vb), l1 = tr_read<v_rd_off(D0, 1, 0)>(vb), h1 = tr_read<v_rd_off(D0, 1, 1)>(vb);
  const s16x4 l2 = tr_read<v_rd_off(D0, 2, 0)>(vb), h2 = tr_read<v_rd_off(D0, 2, 1)>(vb), l3 = tr_read<v_rd_off(D0, 3, 0)>(vb), h3 = tr_read<v_rd_off(D0, 3, 1)>(vb);
  asm volatile("s_waitcnt lgkmcnt(0)" ::: "memory"); SBAR();
#define PK(L, H) (bf16x8){L[0], L[1], L[2], L[3], H[0], H[1], H[2], H[3]}
  od = __builtin_amdgcn_mfma_f32_32x32x16_bf16(pa0, PK(l0, h0), od, 0, 0, 0);
  od = __builtin_amdgcn_mfma_f32_32x32x16_bf16(pa1, PK(l1, h1), od, 0, 0, 0);
  od = __builtin_amdgcn_mfma_f32_32x32x16_bf16(pa2, PK(l2, h2), od, 0, 0, 0);
  od = __builtin_amdgcn_mfma_f32_32x32x16_bf16(pa3, PK(l3, h3), od, 0, 0, 0);
#undef PK
}
__device__ __forceinline__ void pv_d0(f32x16* o, int vb, bf16x8 pa0, bf16x8 pa1, bf16x8 pa2, bf16x8 pa3) {
  pv_one<0>(o[0], vb, pa0, pa1, pa2, pa3); pv_one<1>(o[1], vb, pa0, pa1, pa2, pa3); pv_one<2>(o[2], vb, pa0, pa1, pa2, pa3); pv_one<3>(o[3], vb, pa0, pa1, pa2, pa3);
}

__device__ __forceinline__ void attn_unit(int b, int h, int qb, const bf16_t* __restrict__ Q, const bf16_t* __restrict__ QR, const bf16_t* __restrict__ KN, const bf16_t* __restrict__ KR, const bf16_t* __restrict__ V, bf16_t* __restrict__ O, char* lds) {
  int tid_ = threadIdx.x; asm volatile("" : "+v"(tid_)); const int tid = tid_, wid = __builtin_amdgcn_readfirstlane(tid >> 6), lane = tid & 63, r32 = lane & 31, hi = lane >> 5;
  char* V_lds = lds + OFF_V; char* Kn_lds = lds + OFF_KN; char* Kr_lds = lds + OFF_KR;
  float* ws = (float*)(lds + OFF_WS) + wid * 64; float* li_l = ws; float* al_l = ws + 32;
  const long rowbase = (long)b * SEQ; const int q0 = qb * 256;
  const int NT = (q0 + 256) / KVBLK;
  const int NTw = q0 / KVBLK + (wid >> 1) + 1;
  float m_reg = -1e30f, l_reg = 0; f32x16 o[4] = {}; bf16x8 qr[12];
  { const bf16_t* Qw = Q + (rowbase + q0 + wid * QBLK + r32) * 1024 + h * 128 + hi * 8;
    const bf16_t* Qr = QR + (rowbase + q0 + wid * QBLK + r32) * 512 + h * 64 + hi * 8;
#pragma unroll
    for (int d0 = 0; d0 < 8; ++d0) qr[d0] = *reinterpret_cast<const bf16x8*>(Qw + d0 * 16);
#pragma unroll
    for (int d0 = 0; d0 < 4; ++d0) qr[8 + d0] = *reinterpret_cast<const bf16x8*>(Qr + d0 * 16); }
  const bf16_t* Kh = KN + rowbase * 1024 + h * 128; const bf16_t* Vh = V + rowbase * 1024 + h * 128; const bf16_t* Krh = KR + rowbase * 64;
  const int sr = tid >> 4, sc = (tid & 15) * 8, vst0 = v_st(sr, sc), vst1 = v_st(32 + sr, sc);
  const int krr = tid >> 3, krc = (tid & 7) * 8;
  const int vb0 = (int)(uintptr_t)V_lds + v_rd_base(lane);
  bf16x8 vs0, vs1, ks0, ks1, kr0;
#define SLOAD_A(k0) do { vs0 = *reinterpret_cast<const bf16x8*>(&Vh[(long)((k0) + sr) * 1024 + sc]); vs1 = *reinterpret_cast<const bf16x8*>(&Vh[(long)((k0) + 32 + sr) * 1024 + sc]); } while (0)
#define SLOAD_R(k0) do { ks0 = *reinterpret_cast<const bf16x8*>(&Kh[(long)((k0) + sr) * 1024 + sc]); ks1 = *reinterpret_cast<const bf16x8*>(&Kh[(long)((k0) + 32 + sr) * 1024 + sc]); \
    kr0 = *reinterpret_cast<const bf16x8*>(&Krh[(long)((k0) + krr) * 64 + krc]); } while (0)
#define SLOAD(k0) do { SLOAD_A(k0); SLOAD_R(k0); } while (0)
#define SWRITE(bb) do { *(bf16x8*)(V_lds + (bb) * SHM_V + vst0) = vs0; *(bf16x8*)(V_lds + (bb) * SHM_V + vst1) = vs1; \
    *(bf16x8*)(Kn_lds + (bb) * SHM_KN + KSWZ(sr, sc * 2)) = ks0; *(bf16x8*)(Kn_lds + (bb) * SHM_KN + KSWZ(32 + sr, sc * 2)) = ks1; \
    *(bf16x8*)(Kr_lds + (bb) * SHM_KR + KRSWZ(krr, krc * 2)) = kr0; } while (0)
#define SWAIT() asm volatile("s_waitcnt vmcnt(0)" ::: "memory")
#define RESC(a) do { if (__any((a) < 1.f)) { if (hi == 0) al_l[r32] = (a); asm volatile("s_waitcnt lgkmcnt(0)" ::: "memory"); \
    _Pragma("unroll") for (int d = 0; d < 4; ++d) _Pragma("unroll") for (int r = 0; r < 16; ++r) o[d][r] *= al_l[crow(r, hi)]; } } while (0)
  f32x16 pA0, pA1, pB0, pB1; float mnA, mnB, alA, alB; bf16x8 pa0, pa1, pa2, pa3;
  SLOAD(0); SWAIT(); SWRITE(0); SLOAD(KVBLK); __syncthreads();
  qkt(pA0, pA1, Kn_lds, Kr_lds, qr, r32, hi, true); partialSM(pA0, pA1, m_reg, mnA, alA);
  SWAIT(); SWRITE(1); __syncthreads();
  for (int j = 1; j + 1 < NT; j += 2) {
    SBAR(); SLOAD_A((j + 1) * KVBLK); SBAR();
    qkt(pB0, pB1, Kn_lds + SHM_KN, Kr_lds + SHM_KR, qr, r32, hi, j < NTw);
    finishSM(pA0, pA1, alA, l_reg, pa0, pa1, pa2, pa3); SBAR();
    SLOAD_R((j + 1) * KVBLK); SBAR();
    pv_d0(o, vb0, pa0, pa1, pa2, pa3); partialSM(pB0, pB1, m_reg, mnB, alB);
    __syncthreads(); SWAIT(); SWRITE(0);
    RESC(alB); __syncthreads();
    SBAR(); SLOAD_A((j + 2) * KVBLK); SBAR();
    qkt(pA0, pA1, Kn_lds, Kr_lds, qr, r32, hi, j + 1 < NTw);
    finishSM(pB0, pB1, alB, l_reg, pa0, pa1, pa2, pa3); SBAR();
    SLOAD_R((j + 2) * KVBLK); SBAR();
    pv_d0(o, vb0 + SHM_V, pa0, pa1, pa2, pa3); partialSM(pA0, pA1, m_reg, mnA, alA);
    __syncthreads(); SWAIT(); SWRITE(1);
    RESC(alA); __syncthreads();
  }
  SBAR(); qkt(pB0, pB1, Kn_lds + SHM_KN, Kr_lds + SHM_KR, qr, r32, hi, NT - 1 < NTw);
  finishSM(pA0, pA1, alA, l_reg, pa0, pa1, pa2, pa3); SBAR();
  pv_d0(o, vb0, pa0, pa1, pa2, pa3); partialSM(pB0, pB1, m_reg, mnB, alB);
  __syncthreads(); RESC(alB);
  finishSM(pB0, pB1, alB, l_reg, pa0, pa1, pa2, pa3); SBAR();
  pv_d0(o, vb0 + SHM_V, pa0, pa1, pa2, pa3);
  if (hi == 0) li_l[r32] = l_reg; asm volatile("s_waitcnt lgkmcnt(0)" ::: "memory");
  float rli[16];
#pragma unroll
  for (int r = 0; r < 16; ++r) rli[r] = __builtin_amdgcn_rcpf(li_l[crow(r, hi)]);
  bf16_t* Ow = O + (rowbase + q0 + wid * QBLK) * 1024 + h * 128;
#pragma unroll
  for (int r = 0; r < 16; ++r) { const int orow = crow(r, hi);
#pragma unroll
    for (int d0 = 0; d0 < 4; ++d0) { const float v = o[d0][r] * rli[r]; Ow[(long)orow * 1024 + d0 * 32 + r32] = (bf16_t)(cvtpk(v, v) & 0xffffu); } }
#undef SLOAD
#undef SLOAD_A
#undef SLOAD_R
#undef SWRITE
#undef SWAIT
#undef RESC
}
#undef SBAR
}
typedef unsigned short bf16;
typedef unsigned v4u __attribute__((ext_vector_type(4)));
typedef unsigned v2u __attribute__((ext_vector_type(2)));
typedef float f32x4 __attribute__((ext_vector_type(4)));
#define LAS __attribute__((address_space(3)))
constexpr size_t MiB = 1u << 20;
#define XB_TMO      128
#define XB_XCNT(j)  (256  + 64 * (j))
#define XB_XSUB(j)  (1280 + 64 * (j))
#define XB_XGEN(j)  (2304 + 64 * (j))
#define XB_TOP      3328
#define XB_TOPGEN   3392
#define XCD_BAR_WORDS 3456
#define XB_SPIN_CAP (1u << 18)

__device__ __forceinline__ unsigned xb_ld(unsigned* p)              { return __hip_atomic_load(p, __ATOMIC_RELAXED, __HIP_MEMORY_SCOPE_AGENT); }
__device__ __forceinline__ unsigned xb_add(unsigned* p, unsigned v) { return __hip_atomic_fetch_add(p, v, __ATOMIC_RELAXED, __HIP_MEMORY_SCOPE_AGENT); }
__device__ __forceinline__ unsigned xb_xcc_id() { return (unsigned)__builtin_amdgcn_s_getreg((3 << 11) | 20) & 0xFu; }
#define XB_SPIN(cond, bar) do { unsigned _sp = 0; while (cond) { __builtin_amdgcn_s_sleep(1); \
    if ((++_sp & 255u) == 0u) { if (xb_ld(&(bar)[XB_TMO])) break; if (_sp > XB_SPIN_CAP) { atomicAdd(&(bar)[XB_TMO], 1u); break; } } } } while (0)

struct XcdBarrier {
    unsigned* bar; unsigned x;
    volatile LAS unsigned* st;
};

__device__ __forceinline__ XcdBarrier xcd_barrier_post(unsigned* bar, volatile LAS unsigned* st) {
    XcdBarrier b; b.bar = bar; b.x = xb_xcc_id(); b.st = st;
    if (threadIdx.x == 0) (void)xb_add(&bar[XB_XCNT(b.x)], 1u);
    return b;
}
__device__ __forceinline__ void xcd_barrier_complete(unsigned* bar, unsigned x, unsigned& nloc, unsigned& nx) {
    const unsigned G = gridDim.x * gridDim.y * gridDim.z;
    unsigned sum, cnt, mine, sp = 0u;
    for (;;) {
        sum = 0u; cnt = 0u; mine = 0u;
#pragma unroll
        for (unsigned j = 0; j < 16; ++j) { const unsigned c = xb_ld(&bar[XB_XCNT(j)]); sum += c; cnt += (c > 0u) ? 1u : 0u; mine = (j == x) ? c : mine; }
        if (sum == G) break;
        __builtin_amdgcn_s_sleep(1);
        if ((++sp & 255u) == 0u) { if (xb_ld(&bar[XB_TMO])) break; if (sp > XB_SPIN_CAP) { atomicAdd(&bar[XB_TMO], 1u); break; } }
    }
    nloc = mine > 0u ? mine : 1u; nx = cnt > 0u ? cnt : 1u;
}

__device__ __forceinline__ void xcd_barrier(const XcdBarrier& b) {
    asm volatile("s_waitcnt vmcnt(0)" ::: "memory");
    __syncthreads();
    if (threadIdx.x == 0) {
        unsigned* bar = b.bar;
        __builtin_amdgcn_s_waitcnt(0);
        unsigned nloc = b.st[0], nx = b.st[1];
        if (nloc == 0u) { xcd_barrier_complete(bar, b.x, nloc, nx); b.st[0] = nloc; b.st[1] = nx; }
        const unsigned old = xb_add(&bar[XB_XSUB(b.x)], 1u);
        const unsigned gen = old / nloc;
        if (old + 1u == (gen + 1u) * nloc) {
            __builtin_amdgcn_fence(__ATOMIC_RELEASE, "agent");
            asm volatile("s_waitcnt vmcnt(0)" ::: "memory");
            const unsigned og = xb_add(&bar[XB_TOP], 1u);
            const unsigned tg = og / nx;
            if (og + 1u == (tg + 1u) * nx) xb_add(&bar[XB_TOPGEN], 1u);
            else XB_SPIN(xb_ld(&bar[XB_TOPGEN]) == tg, bar);
            __builtin_amdgcn_fence(__ATOMIC_ACQUIRE, "agent");
            xb_add(&bar[XB_XGEN(b.x)], 1u);
            asm volatile("s_waitcnt vmcnt(0)" ::: "memory");
        } else {
            XB_SPIN(xb_ld(&bar[XB_XGEN(b.x)]) == gen, bar);
            __builtin_amdgcn_fence(__ATOMIC_ACQUIRE, "agent");
            asm volatile("s_waitcnt vmcnt(0)" ::: "memory");
        }
    }
    __syncthreads();
}

constexpr size_t WS_CTL = 0, CTL_ZERO_BYTES = 16384;
constexpr size_t WS_COS = 1 * MiB, WS_SIN = 5 * MiB, WS_W = 10 * MiB;
constexpr size_t WS_SSQ = 604 * MiB;
constexpr size_t WS_XN = 64 * MiB;
constexpr size_t WS_CONV = 128 * MiB;
constexpr size_t WS_Q = WS_CONV, WS_PB = WS_CONV, WS_PP = WS_CONV + 16 * MiB;
constexpr size_t WS_LORA = 224 * MiB;
constexpr size_t WS_QN = 272 * MiB;
constexpr size_t WS_KVN = 296 * MiB;
constexpr size_t WS_ATTN = 224 * MiB;
constexpr size_t WS_GATES = 312 * MiB;
constexpr size_t WS_YCB = 440 * MiB;
constexpr size_t WS_KROPE = 472 * MiB;
constexpr size_t WS_KNOPE = 476 * MiB;
constexpr size_t WS_V = 540 * MiB;
constexpr size_t WS_HB = WS_V;
constexpr size_t WS_HID = 312 * MiB;
constexpr size_t WS_LSSQ = 638 * MiB;
constexpr size_t WS_END = 642 * MiB;
constexpr size_t WO_GU1 = 0, WO_DN1 = WO_GU1 + (size_t)5632 * 1024 * 2, WO_IN = WO_DN1 + (size_t)1024 * 2816 * 2, WO_CO = WO_IN + (size_t)4352 * 1024 * 2,
    WO_UQ = WO_CO + (size_t)1024 * 512 * 2, WO_UKV = WO_UQ + (size_t)1536 * 384 * 2, WO_MO = WO_UKV + (size_t)2048 * 256 * 2, WO_WO = WO_MO + (size_t)1024 * 1024 * 2,
    WO_GU2 = WO_WO + (size_t)1024 * 1024 * 2, WO_DN2 = WO_GU2 + (size_t)5632 * 1024 * 2, WO_PG = WO_DN2 + (size_t)1024 * 2816 * 2, WO_PP = WO_PG + (size_t)1024 * 1024 * 2,
    WO_END = WO_PP + (size_t)1024 * 256 * 2;
static_assert(WS_W + WO_END <= WS_XN && WS_SSQ + 17 * (size_t)MTOK * 64 <= WS_END, "weights / ssq fit");

constexpr int NWAVES = 8, LDS_BYTES = 147456, RING_BYTES = 131072, MISC_OFF = RING_BYTES + 320;

struct Args { const float* in[23]; float* out; unsigned char* ws; };

__device__ __forceinline__ float wave_sum(float v) {
#pragma unroll
    for (int o = 1; o < 64; o <<= 1) v += __shfl_xor(v, o);
    return v;
}
__device__ __forceinline__ unsigned pk2(float lo, float hi) { return pg8::cvt_pk_bf16(lo, hi); }

template <int TYPE> __device__ __forceinline__ int map_src(int n) {
    if (TYPE == 0) return n;
    if (TYPE == 1) { const int pn = n >> 8, w = n & 255; return (w < 128) ? pn * 128 + w : 2816 + pn * 128 + (w - 128); }
    if (TYPE == 2) { if (n < 1536) return n; if (n < 3584) return n - 1536 + 2240; if (n < 4288) return n - 3584 + 1536; return -1; }
    if (TYPE == 3) { if (n < 1024) return (n >> 7) * 192 + (n & 127);
        const int m = n - 1024, head = m >> 6, w = m & 63, grp = w >> 5, within = w & 31, fqq = within >> 3, nn = (within >> 2) & 1, j = within & 3, i = grp * 16 + 4 * fqq + j;
        return head * 192 + 128 + (nn ? 32 : 0) + i; }
      { if (n < 1024) return (n >> 7) * 256 + (n & 127); const int m = n - 1024; return (m >> 7) * 256 + 128 + (m & 127); }
}
template <int TYPE, bool HASG, bool HALVE = false> __device__ __forceinline__ void cvt_item(const float* W, const float* gain, int K, int Nsrc, int Ndst, bf16* WT, LAS float* scr, int item, int lane) {
    const int nblk = Ndst / 64, kb = item / nblk, nb = item % nblk, k0 = 64 * kb, n0 = 64 * nb;
    const int n4 = (lane & 15) * 4, kq = lane >> 4;
    const int src = map_src<TYPE>(n0 + n4);
    const float* wp = W + (size_t)(k0 + kq) * Nsrc + (src >= 0 ? src : 0);
#pragma unroll 8
    for (int it = 0; it < 16; ++it) { const int kk = kq + 4 * it;
        f32x4 v = (src >= 0) ? __builtin_nontemporal_load((const f32x4*)(wp + (size_t)(4 * it) * Nsrc)) : (f32x4){0.f, 0.f, 0.f, 0.f};
        if (HASG) v = v * gain[k0 + kk]; if (HALVE) v = v * 0.5f;
        scr[kk * 64 + ((n4 + 0) ^ kk)] = v.x; scr[kk * 64 + ((n4 + 1) ^ kk)] = v.y; scr[kk * 64 + ((n4 + 2) ^ kk)] = v.z; scr[kk * 64 + ((n4 + 3) ^ kk)] = v.w; }
    asm volatile("s_waitcnt lgkmcnt(0)" ::: "memory");
    const int c = lane & 7;
#pragma unroll
    for (int j = 0; j < 8; ++j) { const int n = (lane >> 3) + 8 * j; float t[8];
#pragma unroll
        for (int i = 0; i < 8; ++i) t[i] = scr[(8 * c + i) * 64 + (n ^ (8 * c + i))];
        v4u o; o.x = pk2(t[0], t[1]); o.y = pk2(t[2], t[3]); o.z = pk2(t[4], t[5]); o.w = pk2(t[6], t[7]);
        *(v4u*)(WT + (size_t)(n0 + n) * K + k0 + 8 * c) = o; }
    asm volatile("s_waitcnt lgkmcnt(0)" ::: "memory");
}
__device__ __forceinline__ void x_row(const float* xrow, bf16* hbrow, float* ssq, int lane) {
    const f32x4* xr = (const f32x4*)xrow + lane;
    f32x4 v[4]; float s = 0.f;
#pragma unroll
    for (int j = 0; j < 4; ++j) { v[j] = xr[64 * j]; s += (v[j].x * v[j].x + v[j].y * v[j].y) + (v[j].z * v[j].z + v[j].w * v[j].w); }
    unsigned long long* o8 = (unsigned long long*)hbrow + lane;
#pragma unroll
    for (int j = 0; j < 4; ++j) o8[64 * j] = (unsigned long long)pk2(v[j].x, v[j].y) | ((unsigned long long)pk2(v[j].z, v[j].w) << 32);
    s = wave_sum(s);
    if (lane < 16) ssq[lane] = (lane == 0) ? s : 0.f;
}
#define CVT_WEIGHTS(LL, WANT_PG, WANT_REST) do                 { \
                    LAS float* scr = (LAS float*)((LAS unsigned char*)lds + wave * 16384); \
                    constexpr int I_GU = 16 * 88, I_DN = 44 * 16, I_IN = 16 * 68, I_CO = 8 * 16, I_UQ = 6 * 24, I_UKV = 4 * 32, I_SQ = 16 * 16, I_PP = 4 * 16; \
                    constexpr int NITEMS = 2 * I_GU + 2 * I_DN + I_IN + I_CO + I_UQ + I_UKV + 3 * I_SQ + I_PP; \
                    const size_t L = (size_t)(LL); \
                    for (int it = gw; it < NITEMS; it += NGW) { \
                        int r = it; \
                        if (r < I_GU) { if (WANT_REST) cvt_item<1, true>(INP(4) + L * 1024 * 5632, INP(3) + L * 1024, 1024, 5632, 5632, (bf16*)(WB + WO_GU1), scr, r, lane); continue; } r -= I_GU; \
                        if (r < I_GU) { if (WANT_REST) cvt_item<1, true>(INP(17) + L * 1024 * 5632, INP(16) + L * 1024, 1024, 5632, 5632, (bf16*)(WB + WO_GU2), scr, r, lane); continue; } r -= I_GU; \
                        if (r < I_DN) { if (WANT_REST) cvt_item<0, false, true>(INP(5) + L * 2816 * 1024, nullptr, 2816, 1024, 1024, (bf16*)(WB + WO_DN1), scr, r, lane); continue; } r -= I_DN; \
                        if (r < I_DN) { if (WANT_REST) cvt_item<0, false, true>(INP(18) + L * 2816 * 1024, nullptr, 2816, 1024, 1024, (bf16*)(WB + WO_DN2), scr, r, lane); continue; } r -= I_DN; \
                        if (r < I_IN) { if (WANT_REST) cvt_item<2, true>(INP(7) + L * 1024 * 4288, INP(6) + L * 1024, 1024, 4288, 4352, (bf16*)(WB + WO_IN), scr, r, lane); continue; } r -= I_IN; \
                        if (r < I_CO) { if (WANT_REST) cvt_item<0, false>(INP(9) + L * 512 * 1024, nullptr, 512, 1024, 1024, (bf16*)(WB + WO_CO), scr, r, lane); continue; } r -= I_CO; \
                        if (r < I_UQ) { if (WANT_REST) cvt_item<3, true>(INP(12) + L * 384 * 1536, INP(10) + L * 384, 384, 1536, 1536, (bf16*)(WB + WO_UQ), scr, r, lane); continue; } r -= I_UQ; \
                        if (r < I_UKV) { if (WANT_REST) cvt_item<4, true>(INP(13) + L * 256 * 2048, INP(11) + L * 256, 256, 2048, 2048, (bf16*)(WB + WO_UKV), scr, r, lane); continue; } r -= I_UKV; \
                        if (r < I_SQ) { if (WANT_REST) cvt_item<0, false>(INP(14) + L * 1024 * 1024, nullptr, 1024, 1024, 1024, (bf16*)(WB + WO_MO), scr, r, lane); continue; } r -= I_SQ; \
                        if (r < I_SQ) { if (WANT_REST) cvt_item<0, false>(INP(15) + L * 1024 * 1024, nullptr, 1024, 1024, 1024, (bf16*)(WB + WO_WO), scr, r, lane); continue; } r -= I_SQ; \
                        if (r < I_SQ) { if (WANT_PG) cvt_item<0, true>(INP(20) + L * 1024 * 1024, INP(19) + L * 1024, 1024, 1024, 1024, (bf16*)(WB + WO_PG), scr, r, lane); continue; } r -= I_SQ; \
                        if (WANT_REST) cvt_item<0, false>(INP(21) + L * 256 * 1024, nullptr, 256, 1024, 1024, (bf16*)(WB + WO_PP), scr, r, lane); \
                    } \
                } while (0)
__global__ void __launch_bounds__(NWAVES * 64, 2) mega_fwd(Args a) {
    extern __shared__ __attribute__((aligned(16))) unsigned char lds[];
    cg::grid_group grid = cg::this_grid();
    const int G = gridDim.x, bx = blockIdx.x, NGW = G * NWAVES;
    const int vcu = (G % 8 == 0) ? (bx % 8) * (G / 8) + bx / 8 : bx;
#define INP(k) ({ int _k = (k); asm volatile("" : "+s"(_k)); a.in[_k]; })
    float* h = a.out;

    for (int u = threadIdx.x; u < (LDS_BYTES - RING_BYTES) / 4; u += NWAVES * 64) ((LAS unsigned*)((LAS unsigned char*)lds + RING_BYTES))[u] = 0u;
    __syncthreads();
    const XcdBarrier bar = xcd_barrier_post((unsigned*)(a.ws + WS_CTL), (volatile LAS unsigned*)((LAS unsigned char*)lds + MISC_OFF) + 8);
    for (int layer = 0; layer < DEPTH; ++layer) {
        for (int step = 0; step < 12; ++step) {
    unsigned char* ws = a.ws; asm volatile("" : "+s"(ws));
    int tid_ = threadIdx.x; asm volatile("" : "+v"(tid_)); const int tid = tid_, lane = tid & 63, wave = __builtin_amdgcn_readfirstlane(tid >> 6), gw = bx * NWAVES + wave;
    float* cosT = (float*)(ws + WS_COS); float* sinT = (float*)(ws + WS_SIN); float* SSQ = (float*)(ws + WS_SSQ);
    bf16* XN = (bf16*)(ws + WS_XN); bf16* CONV = (bf16*)(ws + WS_CONV); bf16* QB = (bf16*)(ws + WS_Q); bf16* PB = (bf16*)(ws + WS_PB); bf16* PP = (bf16*)(ws + WS_PP);
    bf16* LORA = (bf16*)(ws + WS_LORA); bf16* QN = (bf16*)(ws + WS_QN); bf16* KVN = (bf16*)(ws + WS_KVN); bf16* ATT = (bf16*)(ws + WS_ATTN);
    bf16* GATES = (bf16*)(ws + WS_GATES); bf16* YCB = (bf16*)(ws + WS_YCB); bf16* KROPE = (bf16*)(ws + WS_KROPE); bf16* KNOPE = (bf16*)(ws + WS_KNOPE);
    bf16* QNP = (bf16*)((unsigned char*)h + (size_t)MTOK * DM * 2); bf16* QRP = (bf16*)(ws + WS_XN);     float* LSSQ = (float*)(ws + WS_LSSQ); bf16* VB = (bf16*)(ws + WS_V); bf16* HID = (bf16*)(ws + WS_HID); bf16* HB = (bf16*)h;     bf16* HB2 = XN;
    unsigned char* WB = ws + WS_W;
            if (step == 0 && layer > 0) {
                continue;
            } else if (step == 0) {
                CVT_WEIGHTS(layer, true, true);
                if (layer == 0) {
                    const int* pos = (const int*)INP(2);
                    for (int idx = bx * 512 + tid; idx < MTOK * 32; idx += G * 512) {
                        const int m = idx >> 5, i = idx & 31;
                        const float ang = (float)pos[m] * INV_FREQ[i];
                        double rev = (double)ang * 0.15915494309189535; rev -= __builtin_rint(rev);
                        const float rr = (float)(rev * 6.283185307179586);
                        cosT[idx] = __cosf(rr); sinT[idx] = __sinf(rr);
                    }
                    const float* x = INP(0);
                    for (int m = gw; m < MTOK; m += NGW) x_row(x + (size_t)m * DM, HB2 + (size_t)m * DM, SSQ + (size_t)m * 16, lane);
                }
            } else if (step == 4) {
                continue;
            } else if (step == 6) {
                for (int i = 0; i < 1024; ++i) {
                    const int idx = i * G + vcu; if (idx >= 1024) break;
                    const int c = idx & 255, rnd = idx >> 8, bh = c >> 2, s = c & 3;
                    const int qb = (rnd == 0) ? 15 - s : (rnd == 1) ? 11 - s : (rnd == 2) ? 4 + s : s;
                    att::attn_unit(bh >> 3, bh & 7, qb, QNP, QRP, KNOPE, KROPE, VB, ATT, (char*)lds);
                }
            } else {
                if (step == 11 && layer + 1 < DEPTH) { CVT_WEIGHTS(layer + 1, false, true); __syncthreads(); }
                if (step == 1 && layer > 0) { CVT_WEIGHTS(layer, true, false); __syncthreads(); }
                if (step == 5) {
                const float* cw = INP(8) + layer * 3 * 512;
                const int c0 = lane * 8;
                f32x4 w0a = *(const f32x4*)(cw + c0), w0b = *(const f32x4*)(cw + c0 + 4), w1a = *(const f32x4*)(cw + 512 + c0), w1b = *(const f32x4*)(cw + 512 + c0 + 4),
                      w2a = *(const f32x4*)(cw + 1024 + c0), w2b = *(const f32x4*)(cw + 1024 + c0 + 4);
#pragma unroll 4
                for (int m = gw; m < MTOK; m += NGW) {
                    const int t = m & (SEQ - 1);
                    const bf16* cr = CONV + (size_t)m * 1536;
                    f32x4 ya, yb;
                    { f32x4 ca, cb, va, vb; pg8::unpack8(*(const v4u*)(cr + 512 + c0), ca, cb); pg8::unpack8(*(const v4u*)(cr + 1024 + c0), va, vb); ya = w2a * (ca * va); yb = w2b * (cb * vb); }
                    if (t >= 1) { f32x4 ca, cb, va, vb; pg8::unpack8(*(const v4u*)(cr - 1536 + 512 + c0), ca, cb); pg8::unpack8(*(const v4u*)(cr - 1536 + 1024 + c0), va, vb); ya += w1a * (ca * va); yb += w1b * (cb * vb); }
                    if (t >= 2) { f32x4 ca, cb, va, vb; pg8::unpack8(*(const v4u*)(cr - 3072 + 512 + c0), ca, cb); pg8::unpack8(*(const v4u*)(cr - 3072 + 1024 + c0), va, vb); ya += w0a * (ca * va); yb += w0b * (cb * vb); }
                    { f32x4 ba, bb; pg8::unpack8(*(const v4u*)(cr + c0), ba, bb); *(v4u*)(YCB + (size_t)m * 512 + c0) = pg8::pack8(ba * ya, bb * yb); }
                    const bf16* lr = LORA + (size_t)m * 768;
                    if (lane < 32) { const float x1 = pg8::bf_lo((unsigned)lr[640 + lane]), x2 = pg8::bf_lo((unsigned)lr[672 + lane]);
                      const float c = cosT[(size_t)m * 32 + lane], s = sinT[(size_t)m * 32 + lane];
                      KROPE[(size_t)m * 64 + lane] = (bf16)(pk2(x1 * c - x2 * s, 0.f) & 0xffffu); KROPE[(size_t)m * 64 + 32 + lane] = (bf16)(pk2(x2 * c + x1 * s, 0.f) & 0xffffu); }
                }
                }
                if (step == 8) {
                    const float* p = INP(1) + (size_t)layer * MTOK * 256;
                    for (int idx = bx * 512 + tid; idx < MTOK * 256 / 8; idx += G * 512) {
                        const f32x4 x0 = *(const f32x4*)(p + (size_t)idx * 8), x1 = *(const f32x4*)(p + (size_t)idx * 8 + 4);
                        v4u o; o.x = pk2(x0.x, x0.y); o.y = pk2(x0.z, x0.w); o.z = pk2(x1.x, x1.y); o.w = pk2(x1.z, x1.w);
                        *(v4u*)(PB + (size_t)idx * 8) = o;
                    }
                }
                const int ng = (step == 5 || step == 7 || step == 9) ? 2 : 1;
                constexpr size_t SQA = (size_t)MTOK * 16; float* sq0 = SSQ + (size_t)(layer * 4) * SQA;
                for (int gi = 0; gi < ng; ++gi) {
                    pg8::Gemm g; g.M = MTOK; g.lda = 0; pg8::Epi E{}; int sq_off = 0, sq_n4 = 4, sq_stride = 16; float sq_inv = 1.f / DM; E.h = h; E.cosT = cosT; E.sinT = sinT; E.scale = 1.f; E.hb = HB; E.rl = (LAS float*)((LAS unsigned char*)lds + RING_BYTES + 1024);
                    if (step == 1) { g.A = HB2; g.Bt = (const bf16*)(WB + WO_GU1); g.N = 5632; g.K = 1024; E.mode = pg8::EPI_GU; E.o0 = HID; E.ssq_in = sq0; }
                    else if (step == 9 && gi == 0) { g.A = HB; g.Bt = (const bf16*)(WB + WO_GU2); g.N = 5632; g.K = 1024; E.mode = pg8::EPI_GU; E.o0 = HID; E.ssq_in = sq0 + 2 * SQA; }
                    else if (step == 2 || step == 10) { g.A = HID; g.Bt = (const bf16*)(WB + (step == 2 ? WO_DN1 : WO_DN2)); g.N = 1024; g.K = 2816; E.mode = pg8::EPI_RES; E.ssq_out = sq0 + (step == 2 ? 1 : 3) * SQA; E.hsrc = (step == 2) ? HB2 : HB; }
                    else if (step == 3) { g.A = HB; g.Bt = (const bf16*)(WB + WO_IN); g.N = 4352; g.K = 1024; E.mode = pg8::EPI_SPLIT; E.o0 = CONV; E.ld0 = 1536; E.t1 = 6; E.o1 = GATES; E.ld1 = 2048; E.t2 = 14; E.sig1 = 1; E.o2 = LORA; E.ld2 = 768; E.ssq_in = sq0 + SQA; E.lssq = LSSQ; }
                    else if (step == 5 && gi == 0) { g.A = LORA; g.lda = 768; g.Bt = (const bf16*)(WB + WO_UQ); g.N = 1536; g.K = 384; E.mode = pg8::EPI_UQ; E.o0 = QNP; E.o1 = QRP; E.ssq_in = LSSQ; sq_off = 0; sq_n4 = 3; sq_stride = 32; sq_inv = 1.f / 384.f; }
                    else if (step == 5) { g.A = LORA + 384; g.lda = 768; E.ssq_in = LSSQ; sq_off = 12; sq_n4 = 2; sq_stride = 32; sq_inv = 1.f / 256.f; g.Bt = (const bf16*)(WB + WO_UKV); g.N = 2048; g.K = 256; E.mode = pg8::EPI_SPLIT; E.o0 = KNOPE; E.ld0 = 1024; E.t1 = 4; E.o1 = VB; E.ld1 = 1024; E.t2 = 1000; E.o2 = VB; E.ld2 = 1024; }
                    else if (step == 7 && gi == 0) { g.A = ATT; g.Bt = (const bf16*)(WB + WO_MO); g.N = 1024; g.K = 1024; E.mode = pg8::EPI_MO; E.o0 = XN; E.g = GATES; }
                    else if (step == 7) { g.A = YCB; g.Bt = (const bf16*)(WB + WO_CO); g.N = 1024; g.K = 512; E.mode = pg8::EPI_CO; E.o0 = XN; E.g = GATES; }
                    else if (step == 8) { g.A = XN; g.Bt = (const bf16*)(WB + WO_WO); g.N = 1024; g.K = 1024; E.mode = pg8::EPI_RES; E.scale = 1.f; E.ssq_out = sq0 + 2 * SQA; E.hsrc = HB; }
                    else if (step == 9) { g.A = PB; g.Bt = (const bf16*)(WB + WO_PP); g.N = 1024; g.K = 256; E.mode = pg8::EPI_SPLIT; E.o0 = PP; E.ld0 = 1024; E.t1 = 1000; E.t2 = 1000; E.o1 = PP; E.o2 = PP; E.ld1 = 1024; E.ld2 = 1024; }
                    else { g.A = HB; g.Bt = (const bf16*)(WB + WO_PG); g.N = 1024; g.K = 1024; E.mode = pg8::EPI_PLE; E.g = PP; E.ssq_in = sq0 + 3 * SQA; E.ssq_out = sq0 + 4 * SQA; E.hb2 = HB2; }
                    pg8::StaticOrder S; S.init(g.M, g.N, G, bx);
                    if (g.lda == 0) g.lda = g.K;
                    if (E.ssq_in) {
                        pg8::Unit uu;
                        for (int i = 0; S.next(i, uu); ++i)
                            if (tid < 256) { const f32x4* sp = (const f32x4*)(E.ssq_in + (size_t)(uu.pm * 256 + tid) * sq_stride + sq_off); f32x4 s4 = sp[0];
                                for (int q4 = 1; q4 < sq_n4; ++q4) s4 += sp[q4];
                                E.rl[i * 256 + tid] = 1.0f / sqrtf(((s4[0] + s4[1]) + (s4[2] + s4[3])) * sq_inv + EPS); }
                        __syncthreads();
                    }
                    pg8::gemm_phase<pg8::Epi, pg8::StaticOrder, true, true>((LAS unsigned char*)lds, g, S, E);
                }
            }
            if (a.ws == nullptr) grid.sync();     xcd_barrier(bar);
        }
    }
    { const float* gain = INP(22); const int tid = threadIdx.x, lane = tid & 63, wave = __builtin_amdgcn_readfirstlane(tid >> 6), gw = bx * NWAVES + wave;
      const bf16* HB2 = (const bf16*)(a.ws + WS_XN);
      for (int m = gw; m < MTOK; m += NGW) {
          const v4u* xr = (const v4u*)(HB2 + (size_t)m * DM) + lane * 2; f32x4 v[4];
          pg8::unpack8(xr[0], v[0], v[1]); pg8::unpack8(xr[1], v[2], v[3]);
          float s = 0.f;
#pragma unroll
          for (int j = 0; j < 4; ++j) s += (v[j].x * v[j].x + v[j].y * v[j].y) + (v[j].z * v[j].z + v[j].w * v[j].w);
          const float r = 1.0f / sqrtf(wave_sum(s) * (1.f / DM) + EPS);
          const f32x4* gr = (const f32x4*)gain + lane * 4; f32x4* orow = (f32x4*)(h + (size_t)m * DM) + lane * 4;
#pragma unroll
          for (int j = 0; j < 4; ++j) orow[j] = v[j] * r * gr[j];
      } }
}

extern "C" void kernel_launch(void* const* d_in, const int* in_sizes, int n_in, void* d_out, int out_size, void* d_ws, size_t ws_size, hipStream_t stream) {
    static int grid = 0;
    if (grid == 0) {
        if (n_in != 23 || out_size != MTOK * DM || ws_size < WS_END) { fprintf(stderr, "kernel_launch: unexpected shapes: n_in %d out %d ws %zu (need %zu)\n", n_in, out_size, ws_size, (size_t)WS_END); grid = -1; return; }
        int dev = 0, cus = 0, per_cu = 0;
        if (hipGetDevice(&dev) != hipSuccess || hipDeviceGetAttribute(&cus, hipDeviceAttributeMultiprocessorCount, dev) != hipSuccess) { grid = -1; return; }
        if (hipFuncSetAttribute((const void*)mega_fwd, hipFuncAttributeMaxDynamicSharedMemorySize, LDS_BYTES) != hipSuccess) { fprintf(stderr, "kernel_launch: hipFuncSetAttribute failed\n"); grid = -1; return; }
        if (hipOccupancyMaxActiveBlocksPerMultiprocessor(&per_cu, (const void*)mega_fwd, NWAVES * 64, LDS_BYTES) != hipSuccess || per_cu < 1) { fprintf(stderr, "kernel_launch: occupancy query says %d\n", per_cu); per_cu = 1; }
        (void)hipGetLastError();
        grid = cus * per_cu;
    }
    if (grid < 0) return;
    if (hipMemsetAsync((char*)d_ws + WS_CTL, 0, CTL_ZERO_BYTES, stream) != hipSuccess) { fprintf(stderr, "kernel_launch: memset failed\n"); return; }
    Args a{};
    for (int i = 0; i < 23; ++i) a.in[i] = (const float*)d_in[i];
    a.out = (float*)d_out; a.ws = (unsigned char*)d_ws;
    void* args[] = {&a};
    hipError_t e = hipLaunchCooperativeKernel((const void*)mega_fwd, dim3(grid), dim3(NWAVES * 64), args, LDS_BYTES, stream);
    if (e != hipSuccess) fprintf(stderr, "cooperative launch failed: %s (grid %d)\n", hipGetErrorString(e), grid);
}
```

```cpp
#include <hip/hip_runtime.h>
#include <hip/hip_cooperative_groups.h>
#include <cstdio>
#include <cstdint>
namespace cg = cooperative_groups;

constexpr int MTOK = 32768, DM = 1024, DFF = 2816, SEQ = 4096, DEPTH = 4;
constexpr float EPS = 1e-6f;
__constant__ float INV_FREQ[32] = {
 0x1.0000000000000p+0f, 0x1.7ff2220000000p-1f, 0x1.1feb340000000p-1f, 0x1.afd1360000000p-2f, 0x1.43d1360000000p-2f, 0x1.e5a8480000000p-3f, 0x1.6c310e0000000p-3f, 0x1.111aee0000000p-3f,
 0x1.99999a0000000p-4f, 0x1.33281c0000000p-4f, 0x1.ccab860000000p-5f, 0x1.59742a0000000p-5f, 0x1.030dc40000000p-5f, 0x1.8486a00000000p-6f, 0x1.235a720000000p-6f, 0x1.b4f7e20000000p-7f,
 0x1.47ae140000000p-7f, 0x1.eb73600000000p-8f, 0x1.7089380000000p-8f, 0x1.145cee0000000p-8f, 0x1.9e7c6e0000000p-9f, 0x1.36d21a0000000p-9f, 0x1.d22a500000000p-10f, 0x1.5d931c0000000p-10f,
 0x1.0624de0000000p-10f, 0x1.8929180000000p-11f, 0x1.26d42c0000000p-11f, 0x1.ba2e4c0000000p-12f, 0x1.4b96be0000000p-12f, 0x1.f150280000000p-13f, 0x1.74eea60000000p-13f, 0x1.17a8e40000000p-13f};

namespace pg8 {
#define PG8_LAS __attribute__((address_space(3)))
typedef unsigned short bf16_t;
typedef short bf16x8 __attribute__((ext_vector_type(8)));
typedef float f32x4 __attribute__((ext_vector_type(4)));
typedef unsigned u32x4 __attribute__((ext_vector_type(4)));
constexpr int BM = 256, BK = 64, HALF = 128, HTB = HALF * BK * 2  , STAGE_BYTES = 8 * HTB, NXCD = 8, WGM = 8;

__host__ __device__ __forceinline__ int lds_byte(int r, int c) { const int st = (r >> 4) * 2 + (c >> 5), rr = r & 15, cc = c & 31, ob = rr * 64 + cc * 2; return st * 1024 + (ob ^ (((ob >> 9) & 1) << 5)); }
__host__ __device__ __forceinline__ void stage_rc(int b, int& R, int& C) { const int st = b / 1024, sb = b % 1024, swz = sb ^ (((sb >> 9) & 1) << 5); R = (st >> 1) * 16 + swz / 64; C = (st & 1) * 32 + (swz % 64) / 2; }
__host__ __device__ __forceinline__ int perm32(int rho) { const int n = rho >> 4, i = rho & 15; return 8 * (i >> 2) + 4 * n + (i & 3); }

struct Unit { int pm, pn; };
struct Gemm { const bf16_t* A; const bf16_t* Bt; int M, N, K, lda; };

struct StaticOrder {
    int nM, nN, nwg, G, c;
    __host__ __device__ void init(int M, int N, int G_, int c_) { nM = M / BM; nN = N / BM; nwg = nM * nN; G = G_; c = c_; }
    __host__ __device__ bool next(int i, Unit& u) const {
        const long L = (long)i * G + c; if (L >= nwg) return false;
        int wgid = (int)L; { const int q = nwg / NXCD, r = nwg % NXCD, xcd = wgid % NXCD, off = wgid / NXCD; wgid = (xcd < r ? xcd * (q + 1) : r * (q + 1) + (xcd - r) * q) + off; }
        const int nig = WGM * nN, gid = wgid / nig, fm = gid * WGM, gsz = (nM - fm) < WGM ? (nM - fm) : WGM;
        u.pm = fm + ((wgid % nig) % gsz); u.pn = (wgid % nig) / gsz; return true;
    }
    __device__ __forceinline__ void a_ready(const Unit&) const {}
    __device__ __forceinline__ void done(const Unit&) const {}
};

typedef unsigned u32x2 __attribute__((ext_vector_type(2)));
typedef _Float16 h16x8 __attribute__((ext_vector_type(8)));
__device__ __forceinline__ unsigned cvt_pk_bf16(float lo, float hi) { unsigned r; asm volatile("v_cvt_pk_bf16_f32 %0, %1, %2" : "=v"(r) : "v"(lo), "v"(hi)); return r; }
__device__ __forceinline__ float sigm(float x) { return __builtin_amdgcn_rcpf(1.f + __builtin_amdgcn_exp2f(-1.4426950408889634f * x)); }
__device__ __forceinline__ float bf_lo(unsigned w) { return __builtin_bit_cast(float, w << 16); }
__device__ __forceinline__ float bf_hi(unsigned w) { return __builtin_bit_cast(float, w & 0xffff0000u); }
__device__ __forceinline__ u32x4 pack8(const f32x4& a, const f32x4& b) { u32x4 w; w.x = cvt_pk_bf16(a[0], a[1]); w.y = cvt_pk_bf16(a[2], a[3]); w.z = cvt_pk_bf16(b[0], b[1]); w.w = cvt_pk_bf16(b[2], b[3]); return w; }
__device__ __forceinline__ void unpack8(const u32x4& w, f32x4& a, f32x4& b) { a[0] = bf_lo(w.x); a[1] = bf_hi(w.x); a[2] = bf_lo(w.y); a[3] = bf_hi(w.y); b[0] = bf_lo(w.z); b[1] = bf_hi(w.z); b[2] = bf_lo(w.w); b[3] = bf_hi(w.w); }

enum { EPI_GU = 0, EPI_RES = 1, EPI_SPLIT = 2, EPI_UQ = 3, EPI_MO = 4, EPI_CO = 5, EPI_PLE = 6 };
struct Epi {
    int mode; float scale;
    float* h;
    bf16_t* o0; bf16_t* o1; bf16_t* o2; int ld0, ld1, ld2, t1, t2, sig1;
    const bf16_t* g;
    const float* cosT; const float* sinT;
    const float* ssq_in; float* ssq_out; bf16_t* hb; bf16_t* hb2; const bf16_t* hsrc; float* lssq; PG8_LAS float* rl;
    mutable int ui;
    __device__ __forceinline__ void init_acc(f32x4 (&acc)[2][2][4][2], const Unit& u, int wr, int wc, int fr, int fq) const {
        if (mode == EPI_RES) {
            const bf16_t* base = hsrc + (size_t)(u.pm * BM + wr * 64 + fr) * DM + u.pn * BM + wc * 32 + 8 * fq;
            u32x4 t[2][4][2];
#pragma unroll
            for (int ai = 0; ai < 2; ++ai)
#pragma unroll
                for (int m = 0; m < 4; ++m)
#pragma unroll
                    for (int bj = 0; bj < 2; ++bj) t[ai][m][bj] = *(const u32x4*)(base + (size_t)(ai * HALF + m * 16) * DM + bj * HALF);
#pragma unroll
            for (int ai = 0; ai < 2; ++ai)
#pragma unroll
                for (int m = 0; m < 4; ++m)
#pragma unroll
                    for (int bj = 0; bj < 2; ++bj) unpack8(t[ai][m][bj], acc[ai][bj][m][0], acc[ai][bj][m][1]);
        } else {
#pragma unroll
            for (int ai = 0; ai < 2; ++ai)
#pragma unroll
                for (int bj = 0; bj < 2; ++bj)
#pragma unroll
                    for (int m = 0; m < 4; ++m) { acc[ai][bj][m][0] = (f32x4){0.f, 0.f, 0.f, 0.f}; acc[ai][bj][m][1] = (f32x4){0.f, 0.f, 0.f, 0.f}; }
        }
    }
    __device__ __forceinline__ void operator()(f32x4 (&acc)[2][2][4][2], const Unit& u, int wr, int wc, int fr, int fq) const {
        const int row0 = u.pm * BM + wr * 64 + fr;
        float rs[2][4];
        if (ssq_in) {
#pragma unroll
            for (int ai = 0; ai < 2; ++ai)
#pragma unroll
                for (int m = 0; m < 4; ++m) rs[ai][m] = rl[ui * BM + wr * 64 + ai * HALF + m * 16 + fr];
        } else {
#pragma unroll
            for (int ai = 0; ai < 2; ++ai)
#pragma unroll
                for (int m = 0; m < 4; ++m) rs[ai][m] = 1.f;
        }
        ++ui;
        if (mode == EPI_GU) {
            const int col = u.pn * 128 + wc * 32 + 8 * fq;
#pragma unroll
            for (int ai = 0; ai < 2; ++ai)
#pragma unroll
                for (int m = 0; m < 4; ++m) { f32x4 r0, r1;
#pragma unroll
                    for (int j = 0; j < 4; ++j) { const float g0 = acc[ai][0][m][0][j] * rs[ai][m], g1 = acc[ai][0][m][1][j] * rs[ai][m]; r0[j] = g0 * sigm(g0) * (acc[ai][1][m][0][j] * rs[ai][m]); r1[j] = g1 * sigm(g1) * (acc[ai][1][m][1][j] * rs[ai][m]); }
                    *(u32x4*)(o0 + (size_t)(row0 + ai * HALF + m * 16) * DFF + col) = pack8(r0, r1); }
        } else if (mode == EPI_RES) {
#pragma unroll
            for (int ai = 0; ai < 2; ++ai)
#pragma unroll
                for (int m = 0; m < 4; ++m) { const size_t row = (size_t)(row0 + ai * HALF + m * 16); const int col = u.pn * BM + wc * 32 + 8 * fq; float sq = 0.f;
#pragma unroll
                    for (int bj = 0; bj < 2; ++bj) { const f32x4 a = acc[ai][bj][m][0], b = acc[ai][bj][m][1];
                        *(u32x4*)(hb + row * DM + col + bj * HALF) = pack8(a, b);
                        sq += (a[0] * a[0] + a[1] * a[1]) + (a[2] * a[2] + a[3] * a[3]) + (b[0] * b[0] + b[1] * b[1]) + (b[2] * b[2] + b[3] * b[3]); }
                    sq += __shfl_xor(sq, 16); sq += __shfl_xor(sq, 32);
                    if (fq == 0) ssq_out[row * 16 + u.pn * 4 + wc] = sq;
                    }
        } else if (mode == EPI_SPLIT) {
            bf16_t* base; int ld, colt; bool sg = false;
            if (u.pn < t1) { base = o0; ld = ld0; colt = u.pn * BM; } else if (u.pn < t2) { base = o1; ld = ld1; colt = (u.pn - t1) * BM; sg = sig1 != 0; } else { base = o2; ld = ld2; colt = (u.pn - t2) * BM; }
#pragma unroll
            for (int ai = 0; ai < 2; ++ai)
#pragma unroll
                for (int m = 0; m < 4; ++m) { bf16_t* rowp = base + (size_t)(row0 + ai * HALF + m * 16) * ld + colt + wc * 32 + 8 * fq;
#pragma unroll
                    for (int bj = 0; bj < 2; ++bj) { f32x4 a = acc[ai][bj][m][0] * rs[ai][m], b = acc[ai][bj][m][1] * rs[ai][m];
                        if (sg) {
#pragma unroll
                            for (int j = 0; j < 4; ++j) { a[j] = sigm(a[j]); b[j] = sigm(b[j]); } }
                        *(u32x4*)(rowp + bj * HALF) = pack8(a, b);
                        if (lssq && u.pn >= t2) {
                            float sq = (a[0] * a[0] + a[1] * a[1]) + (a[2] * a[2] + a[3] * a[3]) + (b[0] * b[0] + b[1] * b[1]) + (b[2] * b[2] + b[3] * b[3]);
                            sq += __shfl_xor(sq, 16); sq += __shfl_xor(sq, 32);
                            if (fq == 0) lssq[(size_t)(row0 + ai * HALF + m * 16) * 32 + (u.pn - t2) * 8 + bj * 4 + wc] = sq; } } }
        } else if (mode == EPI_UQ) {
            if (u.pn < 4) {
#pragma unroll
                for (int ai = 0; ai < 2; ++ai)
#pragma unroll
                    for (int m = 0; m < 4; ++m) { bf16_t* rowp = o0 + (size_t)(row0 + ai * HALF + m * 16) * 1024 + u.pn * BM + wc * 32 + 8 * fq;
#pragma unroll
                        for (int bj = 0; bj < 2; ++bj) *(u32x4*)(rowp + bj * HALF) = pack8(acc[ai][bj][m][0] * rs[ai][m], acc[ai][bj][m][1] * rs[ai][m]); }
            } else {
                const int i0 = (wc & 1) * 16 + 4 * fq;
#pragma unroll
                for (int ai = 0; ai < 2; ++ai)
#pragma unroll
                    for (int m = 0; m < 4; ++m) { const int row = row0 + ai * HALF + m * 16;
                        const f32x4 cs = *(const f32x4*)(cosT + (size_t)row * 32 + i0), sn = *(const f32x4*)(sinT + (size_t)row * 32 + i0);
#pragma unroll
                        for (int bj = 0; bj < 2; ++bj) { const int head = (u.pn - 4) * 4 + 2 * bj + (wc >> 1);
                            const f32x4 x1 = acc[ai][bj][m][0] * rs[ai][m], x2 = acc[ai][bj][m][1] * rs[ai][m]; const f32x4 y1 = x1 * cs - x2 * sn, y2 = x2 * cs + x1 * sn;
                            bf16_t* p = o1 + (size_t)row * 512 + head * 64 + i0;
                            u32x2 w1, w2; w1.x = cvt_pk_bf16(y1[0], y1[1]); w1.y = cvt_pk_bf16(y1[2], y1[3]); w2.x = cvt_pk_bf16(y2[0], y2[1]); w2.y = cvt_pk_bf16(y2[2], y2[3]);
                            *(u32x2*)p = w1; *(u32x2*)(p + 32) = w2; } }
            }
        } else if (mode == EPI_MO || mode == EPI_CO) {
            const int goff = (mode == EPI_MO) ? 1024 : 0;
#pragma unroll
            for (int ai = 0; ai < 2; ++ai)
#pragma unroll
                for (int m = 0; m < 4; ++m) { const size_t row = (size_t)(row0 + ai * HALF + m * 16); const int col = u.pn * BM + wc * 32 + 8 * fq;
#pragma unroll
                    for (int bj = 0; bj < 2; ++bj) { f32x4 ga, gb; unpack8(*(const u32x4*)(g + row * 2048 + goff + col + bj * HALF), ga, gb);
                        f32x4 a = ga * acc[ai][bj][m][0], b = gb * acc[ai][bj][m][1];
                        bf16_t* p = o0 + row * DM + col + bj * HALF;
                        if (mode == EPI_CO) { f32x4 pa, pb; unpack8(*(const u32x4*)p, pa, pb); a += pa; b += pb; }
                        *(u32x4*)p = pack8(a, b); } }
        } else {
#pragma unroll
            for (int ai = 0; ai < 2; ++ai)
#pragma unroll
                for (int m = 0; m < 4; ++m) { const size_t row = (size_t)(row0 + ai * HALF + m * 16); const int col = u.pn * BM + wc * 32 + 8 * fq; float sq = 0.f;
#pragma unroll
                    for (int bj = 0; bj < 2; ++bj) { f32x4 pa, pb, a, b; unpack8(*(const u32x4*)(g + row * DM + col + bj * HALF), pa, pb); unpack8(*(const u32x4*)(hb + row * DM + col + bj * HALF), a, b);
#pragma unroll
                        for (int j = 0; j < 4; ++j) { a[j] += sigm(acc[ai][bj][m][0][j] * rs[ai][m]) * pa[j]; b[j] += sigm(acc[ai][bj][m][1][j] * rs[ai][m]) * pb[j]; }
                        *(u32x4*)(hb2 + row * DM + col + bj * HALF) = pack8(a, b);
                        sq += (a[0] * a[0] + a[1] * a[1]) + (a[2] * a[2] + a[3] * a[3]) + (b[0] * b[0] + b[1] * b[1]) + (b[2] * b[2] + b[3] * b[3]); }
                    sq += __shfl_xor(sq, 16); sq += __shfl_xor(sq, 32);
                    if (fq == 0) ssq_out[row * 16 + u.pn * 4 + wc] = sq;
                    }
        }
    }
};
template <class Epi, class Sched, bool ALIGN_EPI = false, bool SP2 = false>
__device__ __forceinline__ void gemm_phase(PG8_LAS unsigned char* lds, const Gemm g, const Sched& S, const Epi& E) {
    int tid_ = threadIdx.x; asm volatile("" : "+v"(tid_)); const int tid = tid_, wid = __builtin_amdgcn_readfirstlane(tid >> 6), lane = tid & 63, wr = wid >> 2, wc = wid & 3, fr = lane & 15, fq = lane >> 4;
    const int K = g.K, nt = K / BK;
    unsigned voffA[2], voffB[2];
#pragma unroll
    for (int i = 0; i < 2; ++i) { int R, C; stage_rc(tid * 16 + i * 8192, R, C); const int Rb = true ? ((R & ~31) + perm32(R & 31)) : R;
        voffA[i] = (unsigned)(R * g.lda + C) * 2u; voffB[i] = (unsigned)(Rb * K + C) * 2u; }
    const size_t kstep = (size_t)(BK * 2);
    const size_t hstepA = (size_t)HALF * g.lda * 2, hstep = (size_t)HALF * K * 2;
    const size_t tstepA = 2 * hstepA, tstep = 2 * hstep;
    const unsigned ldsw = (unsigned)wid * 1024u;
    const int aoff = lds_byte(wr * 64 + fr, fq * 8), boff = lds_byte(wc * 32 + fr, fq * 8);
#define PG8_SA(b, h) (((b) * 2 + (h)) * HTB)
#define PG8_SB(b, h) ((4 + (b) * 2 + (h)) * HTB)
#define PG8_STAGE(bufoff, gbase, voff) do { _Pragma("unroll") for (int _i = 0; _i < 2; ++_i) \
        __builtin_amdgcn_global_load_lds((const unsigned*)((const char*)(gbase) + (voff)[_i]), (PG8_LAS unsigned*)(lds + (bufoff) + ldsw + _i * 8192), 16, 0, 0); } while (0)
#define PG8_LDA(dst, b, h) do { _Pragma("unroll") for (int m = 0; m < 4; ++m) _Pragma("unroll") for (int k = 0; k < 2; ++k) dst[m][k] = *(const PG8_LAS bf16x8*)(lds + PG8_SA(b, h) + aoff + m * 2048 + k * 1024); } while (0)
#define PG8_LDB(dst, b, h) do { _Pragma("unroll") for (int n = 0; n < 2; ++n) _Pragma("unroll") for (int k = 0; k < 2; ++k) dst[n][k] = *(const PG8_LAS bf16x8*)(lds + PG8_SB(b, h) + boff + n * 2048 + k * 1024); } while (0)
#define PG8_MMA(ai, bj, At, Bt) do { __builtin_amdgcn_s_setprio(1); _Pragma("unroll") for (int m = 0; m < 4; ++m) _Pragma("unroll") for (int n = 0; n < 2; ++n) _Pragma("unroll") for (int k = 0; k < 2; ++k) \
        acc[ai][bj][m][n] = __builtin_amdgcn_mfma_f32_16x16x32_bf16(Bt[n][k], At[m][k], acc[ai][bj][m][n], 0, 0, 0); __builtin_amdgcn_s_setprio(0); } while (0)
#define PG8_WAIT_V(n) asm volatile("s_waitcnt vmcnt(" #n ")" ::: "memory")
#define PG8_WAIT_L(n) asm volatile("s_waitcnt lgkmcnt(" #n ")" ::: "memory")
#define PG8_BAR __builtin_amdgcn_s_barrier()
#define PG8_SCHED __builtin_amdgcn_sched_barrier(0)
    Unit cur, nxt; int ui = 0;
    if (!S.next(0, cur)) return;
    f32x4 acc[2][2][4][2];
    E.init_acc(acc, cur, wr, wc, fr, fq);
    bf16x8 At[4][2], B0[2][2], B1[2][2];
    const char* cA = (const char*)g.A + (size_t)cur.pm * tstepA; const char* cB = (const char*)g.Bt + (size_t)cur.pn * tstep;
    S.a_ready(cur);
    if constexpr (SP2) {
        PG8_STAGE(PG8_SB(0, 0), cB, voffB); PG8_STAGE(PG8_SB(0, 1), cB + hstep, voffB); PG8_STAGE(PG8_SA(0, 0), cA, voffA); PG8_STAGE(PG8_SA(0, 1), cA + hstepA, voffA);
        if (wr == 1) PG8_BAR;
        PG8_WAIT_V(2); PG8_BAR;
        PG8_STAGE(PG8_SB(1, 0), cB + kstep, voffB); PG8_STAGE(PG8_SA(1, 0), cA + kstep, voffA); PG8_STAGE(PG8_SB(1, 1), cB + hstep + kstep, voffB);
        PG8_WAIT_V(6); PG8_BAR;
    } else {
        PG8_STAGE(PG8_SB(0, 0), cB, voffB); PG8_STAGE(PG8_SA(0, 0), cA, voffA); PG8_STAGE(PG8_SB(0, 1), cB + hstep, voffB); PG8_STAGE(PG8_SA(0, 1), cA + hstepA, voffA);
        if (wr == 1) PG8_BAR;
        PG8_WAIT_V(4); PG8_BAR;
        PG8_STAGE(PG8_SB(1, 0), cB + kstep, voffB); PG8_STAGE(PG8_SA(1, 0), cA + kstep, voffA); PG8_STAGE(PG8_SB(1, 1), cB + hstep + kstep, voffB);
        PG8_WAIT_V(6); PG8_BAR;
    }
    for (;;) {
        const bool has_next = S.next(ui + 1, nxt);
        const char* nA = has_next ? (const char*)g.A + (size_t)nxt.pm * tstepA : cA; const char* nB = has_next ? (const char*)g.Bt + (size_t)nxt.pn * tstep : cB;
        for (int t = 0; t < nt; t += 2) {
            const bool last = (t == nt - 2);
            const char* a1 = cA + (size_t)(t + 1) * kstep;
            const char* a2 = last ? nA : cA + (size_t)(t + 2) * kstep; const char* b2 = last ? nB : cB + (size_t)(t + 2) * kstep;
            const char* a3 = a2 + kstep; const char* b3 = b2 + kstep;
            if (last && has_next) S.a_ready(nxt);
            if constexpr (SP2) {
            PG8_LDB(B0, 0, 0); PG8_LDB(B1, 0, 1); PG8_SCHED; PG8_LDA(At, 0, 0); PG8_STAGE(PG8_SA(1, 1), a1 + hstepA, voffA);
            PG8_WAIT_V(8); PG8_WAIT_L(0); PG8_BAR; PG8_MMA(0, 0, At, B0); PG8_MMA(0, 1, At, B1); PG8_BAR; PG8_SCHED;
            PG8_LDA(At, 0, 1); PG8_STAGE(PG8_SB(0, 0), b2, voffB); PG8_STAGE(PG8_SB(0, 1), b2 + hstep, voffB); PG8_STAGE(PG8_SA(0, 0), a2, voffA);
            PG8_WAIT_V(8); PG8_WAIT_L(0); PG8_BAR; PG8_MMA(1, 0, At, B0); PG8_MMA(1, 1, At, B1); PG8_BAR; PG8_SCHED;
            PG8_LDB(B0, 1, 0); PG8_LDB(B1, 1, 1); PG8_SCHED; PG8_LDA(At, 1, 0); PG8_STAGE(PG8_SA(0, 1), a2 + hstepA, voffA);
            PG8_WAIT_V(8); PG8_WAIT_L(0); PG8_BAR; PG8_MMA(0, 0, At, B0); PG8_MMA(0, 1, At, B1); PG8_BAR; PG8_SCHED;
            PG8_LDA(At, 1, 1); PG8_STAGE(PG8_SB(1, 0), b3, voffB); PG8_STAGE(PG8_SB(1, 1), b3 + hstep, voffB); PG8_STAGE(PG8_SA(1, 0), a3, voffA);
            PG8_WAIT_V(8); PG8_WAIT_L(0); PG8_BAR; PG8_MMA(1, 0, At, B0); PG8_MMA(1, 1, At, B1); PG8_BAR; PG8_SCHED;
            } else {
            PG8_LDB(B0, 0, 0); PG8_SCHED; PG8_LDA(At, 0, 0); PG8_STAGE(PG8_SA(1, 1), a1 + hstepA, voffA);
            PG8_WAIT_L(8); PG8_BAR; PG8_WAIT_L(0); PG8_MMA(0, 0, At, B0); PG8_BAR; PG8_SCHED;
            PG8_LDB(B1, 0, 1); PG8_STAGE(PG8_SB(0, 0), b2, voffB);
            PG8_BAR; PG8_WAIT_L(0); PG8_MMA(0, 1, At, B1); PG8_BAR;
            PG8_LDA(At, 0, 1); PG8_STAGE(PG8_SA(0, 0), a2, voffA);
            PG8_BAR; PG8_WAIT_L(0); PG8_MMA(1, 0, At, B0); PG8_BAR; PG8_SCHED;
            PG8_STAGE(PG8_SB(0, 1), b2 + hstep, voffB);
            PG8_WAIT_V(6); PG8_BAR; PG8_MMA(1, 1, At, B1); PG8_BAR;
            PG8_LDB(B0, 1, 0); PG8_SCHED; PG8_LDA(At, 1, 0); PG8_STAGE(PG8_SA(0, 1), a2 + hstepA, voffA);
            PG8_WAIT_L(8); PG8_BAR; PG8_WAIT_L(0); PG8_MMA(0, 0, At, B0); PG8_BAR; PG8_SCHED;
            PG8_LDB(B1, 1, 1); PG8_STAGE(PG8_SB(1, 0), b3, voffB);
            PG8_BAR; PG8_WAIT_L(0); PG8_MMA(0, 1, At, B1); PG8_BAR;
            PG8_LDA(At, 1, 1); PG8_STAGE(PG8_SA(1, 0), a3, voffA);
            PG8_BAR; PG8_WAIT_L(0); PG8_MMA(1, 0, At, B0); PG8_BAR; PG8_SCHED;
            PG8_STAGE(PG8_SB(1, 1), b3 + hstep, voffB);
            PG8_WAIT_V(6); PG8_BAR; PG8_MMA(1, 1, At, B1); PG8_BAR;
            }
        }
        if constexpr (ALIGN_EPI) { if (wr == 0) PG8_BAR; }
        if constexpr (!false) { E(acc, cur, wr, wc, fr, fq); S.done(cur); }
        if (!has_next) break;
        E.init_acc(acc, nxt, wr, wc, fr, fq);
        cur = nxt; cA = nA; cB = nB; ++ui;
        if constexpr (ALIGN_EPI) { if (wr == 1) PG8_BAR; }
    }
    PG8_WAIT_V(0);
    if constexpr (!ALIGN_EPI) { if (wr == 0) PG8_BAR; }
    PG8_BAR;
    if constexpr (false) { E.fused(acc, cur, wr, wc, fr, fq, lds, wid, lane); S.done(cur); }
#undef PG8_SA
#undef PG8_SB
#undef PG8_STAGE
#undef PG8_LDA
#undef PG8_LDB
#undef PG8_MMA
#undef PG8_WAIT_V
#undef PG8_WAIT_L
#undef PG8_BAR
#undef PG8_SCHED
}
}
namespace att {
using bf16x8 = __attribute__((ext_vector_type(8))) short;
using s16x4  = __attribute__((ext_vector_type(4))) short;
using f32x16 = __attribute__((ext_vector_type(16))) float;
using u32x4  = __attribute__((ext_vector_type(4))) unsigned;
typedef unsigned short bf16_t;
constexpr int NW = 8, QBLK = 32, KVBLK = 64;
constexpr float SCALE = 0.07216878364870322f;
constexpr float THR = 8.f;
constexpr int SHM_V = 16384, SHM_KN = 16384, SHM_KR = 8192;
constexpr int OFF_V = 0, OFF_KN = 2 * SHM_V, OFF_KR = OFF_KN + 2 * SHM_KN, OFF_WS = OFF_KR + 2 * SHM_KR, LDS_BYTES = OFF_WS + NW * 64 * 4;
#define KSWZ(row, colB) ((row) * 256 + ((colB) ^ (((row) & 7) << 4)))
#define KRSWZ(row, colB) ((row) * 128 + ((colB) ^ ((((row) >> 1) & 7) << 4)))
#define SBAR() __builtin_amdgcn_sched_barrier(0)
__device__ __forceinline__ int crow(int r, int hi) { return (r & 3) + 8 * (r >> 2) + 4 * hi; }
__device__ __forceinline__ unsigned cvtpk(float lo, float hi) { unsigned r; asm volatile("v_cvt_pk_bf16_f32 %0, %1, %2" : "=v"(r) : "v"(lo), "v"(hi)); return r; }

__device__ __forceinline__ void partialSM(f32x16& p0, f32x16& p1, float& m_reg, float& mn, float& alpha) {
  constexpr float C = SCALE * 1.4426950408889634f;
  float pmax = p0[0];
#pragma unroll
  for (int r = 1; r < 16; ++r) pmax = fmaxf(pmax, p0[r]);
#pragma unroll
  for (int r = 0; r < 16; ++r) pmax = fmaxf(pmax, p1[r]);
  { auto rr = __builtin_amdgcn_permlane32_swap(__float_as_uint(pmax), __float_as_uint(pmax), false, false);
    pmax = fmaxf(__uint_as_float(rr[0]), __uint_as_float(rr[1])); }
  if (__builtin_expect(__all(pmax - m_reg <= THR / SCALE), 1)) { mn = m_reg; alpha = 1.f; }
  else { mn = fmaxf(m_reg, pmax); alpha = __builtin_amdgcn_exp2f((m_reg - mn) * C); m_reg = mn; }
  float mnC = -mn * C;
#pragma unroll
  for (int r = 0; r < 16; ++r) p0[r] = fmaf(p0[r], C, mnC);
#pragma unroll
  for (int r = 0; r < 16; ++r) p1[r] = fmaf(p1[r], C, mnC);
#pragma unroll
  for (int r = 0; r < 16; ++r) p0[r] = __builtin_amdgcn_exp2f(p0[r]);
}
__device__ __forceinline__ void finishSM(f32x16& p0, f32x16& p1, float alpha, float& l_reg, bf16x8& pa0, bf16x8& pa1, bf16x8& pa2, bf16x8& pa3) {
#pragma unroll
  for (int r = 0; r < 16; ++r) p1[r] = __builtin_amdgcn_exp2f(p1[r]);
  float ps = 0;
#pragma unroll
  for (int r = 0; r < 16; ++r) ps += p0[r];
#pragma unroll
  for (int r = 0; r < 16; ++r) ps += p1[r];
  { auto rr = __builtin_amdgcn_permlane32_swap(__float_as_uint(ps), __float_as_uint(ps), false, false);
    ps = __uint_as_float(rr[0]) + __uint_as_float(rr[1]); }
  l_reg = l_reg * alpha + ps;
#define PK4(P, BASE, OUT) do { unsigned a0 = cvtpk(P[BASE + 0], P[BASE + 1]), a1 = cvtpk(P[BASE + 2], P[BASE + 3]);   \
    unsigned b0 = cvtpk(P[BASE + 4], P[BASE + 5]), b1 = cvtpk(P[BASE + 6], P[BASE + 7]);                              \
    auto r0 = __builtin_amdgcn_permlane32_swap(a0, b0, false, false); auto r1 = __builtin_amdgcn_permlane32_swap(a1, b1, false, false); \
    u32x4 w = {r0[0], r1[0], r0[1], r1[1]}; OUT = *reinterpret_cast<bf16x8*>(&w); } while (0)
  PK4(p0, 0, pa0); PK4(p0, 8, pa1); PK4(p1, 0, pa2); PK4(p1, 8, pa3);
#undef PK4
}
__device__ __forceinline__ void qkt(f32x16& p0, f32x16& p1, const char* Kn, const char* Kr, const bf16x8* qr, int r32, int hi, bool live) {
  if (live) {
    p0 = f32x16{}; p1 = f32x16{};
#pragma unroll
    for (int d0 = 0; d0 < 8; ++d0) { const int cb = (d0 * 16 + hi * 8) * 2;
      bf16x8 b0 = *reinterpret_cast<const bf16x8*>(Kn + KSWZ(r32, cb));
      bf16x8 b1 = *reinterpret_cast<const bf16x8*>(Kn + KSWZ(32 + r32, cb));
      p0 = __builtin_amdgcn_mfma_f32_32x32x16_bf16(b0, qr[d0], p0, 0, 0, 0);
      p1 = __builtin_amdgcn_mfma_f32_32x32x16_bf16(b1, qr[d0], p1, 0, 0, 0); }
#pragma unroll
    for (int d0 = 0; d0 < 4; ++d0) { const int cb = (d0 * 16 + hi * 8) * 2;
      bf16x8 b0 = *reinterpret_cast<const bf16x8*>(Kr + KRSWZ(r32, cb));
      bf16x8 b1 = *reinterpret_cast<const bf16x8*>(Kr + KRSWZ(32 + r32, cb));
      p0 = __builtin_amdgcn_mfma_f32_32x32x16_bf16(b0, qr[8 + d0], p0, 0, 0, 0);
      p1 = __builtin_amdgcn_mfma_f32_32x32x16_bf16(b1, qr[8 + d0], p1, 0, 0, 0); }
  } else {
#pragma unroll
    for (int r = 0; r < 16; ++r) { p0[r] = -1e30f; p1[r] = -1e30f; }
  }
}
__device__ __forceinline__ int v_st(int k, int c) { const int kk = (k & ~0xC) | ((k & 4) << 1) | ((k & 8) >> 1); return ((kk >> 3) * 4 + (c >> 5)) * 512 + ((kk & 7) * 32 + (c & 31)) * 2; }
__device__ __forceinline__ int v_rd_base(int lane) { return ((lane & 3) << 3) | (((lane >> 2) & 3) << 6) | (((lane >> 4) & 1) << 5) | (((lane >> 5) & 1) << 8); }
constexpr int v_rd_off(int d0, int ks, int half) { return d0 * 512 + ks * 4096 + half * 2048; }
template <int OFF> __device__ __forceinline__ s16x4 tr_read(int vb) {
  s16x4 r; asm volatile("ds_read_b64_tr_b16 %0, %1 offset:%2" : "=&v"(r) : "v"(vb), "i"(OFF) : "memory"); return r;
}
template <int D0> __device__ __forceinline__ void pv_one(f32x16& od, int vb, bf16x8 pa0, bf16x8 pa1, bf16x8 pa2, bf16x8 pa3) {
  const s16x4 l0 = tr_read<v_rd_off(D0, 0, 0)>(vb), h0 = tr_read<v_rd_off(D0, 0, 1)>(vb), l1 = tr_read<v_rd_off(D0, 1, 0)>(vb), h1 = tr_read<v_rd_off(D0, 1, 1)>(vb);
  const s16x4 l2 = tr_read<v_rd_off(D0, 2, 0)>(vb), h2 = tr_read<v_rd_off(D0, 2, 1)>(vb), l3 = tr_read<v_rd_off(D0, 3, 0)>(vb), h3 = tr_read<v_rd_off(D0, 3, 1)>(vb);
  asm volatile("s_waitcnt lgkmcnt(0)" ::: "memory"); SBAR();
#define PK(L, H) (bf16x8){L[0], L[1], L[2], L[3], H[0], H[1], H[2], H[3]}
  od = __builtin_amdgcn_mfma_f32_32x32x16_bf16(pa0, PK(l0, h0), od, 0, 0, 0);
  od = __builtin_amdgcn_mfma_f32_32x32x16_bf16(pa1, PK(l1, h1), od, 0, 0, 0);
  od = __builtin_amdgcn_mfma_f32_32x32x16_bf16(pa2, PK(l2, h2), od, 0, 0, 0);
  od = __builtin_amdgcn_mfma_f32_32x32x16_bf16(pa3, PK(l3, h3), od, 0, 0, 0);
#undef PK
}
__device__ __forceinline__ void pv_d0(f32x16* o, int vb, bf16x8 pa0, bf16x8 pa1, bf16x8 pa2, bf16x8 pa3) {
  pv_one<0>(o[0], vb, pa0, pa1, pa2, pa3); pv_one<1>(o[1], vb, pa0, pa1, pa2, pa3); pv_one<2>(o[2], vb, pa0, pa1, pa2, pa3); pv_one<3>(o[3], vb, pa0, pa1, pa2, pa3);
}

__device__ __forceinline__ void attn_unit(int b, int h, int qb, const bf16_t* __restrict__ Q, const bf16_t* __restrict__ QR, const bf16_t* __restrict__ KN, const bf16_t* __restrict__ KR, const bf16_t* __restrict__ V, bf16_t* __restrict__ O, char* lds) {
  int tid_ = threadIdx.x; asm volatile("" : "+v"(tid_)); const int tid = tid_, wid = __builtin_amdgcn_readfirstlane(tid >> 6), lane = tid & 63, r32 = lane & 31, hi = lane >> 5;
  char* V_lds = lds + OFF_V; char* Kn_lds = lds + OFF_KN; char* Kr_lds = lds + OFF_KR;
  float* ws = (float*)(lds + OFF_WS) + wid * 64; float* li_l = ws; float* al_l = ws + 32;
  const long rowbase = (long)b * SEQ; const int q0 = qb * 256;
  const int NT = (q0 + 256) / KVBLK;
  const int NTw = q0 / KVBLK + (wid >> 1) + 1;
  float m_reg = -1e30f, l_reg = 0; f32x16 o[4] = {}; bf16x8 qr[12];
  { const bf16_t* Qw = Q + (rowbase + q0 + wid * QBLK + r32) * 1024 + h * 128 + hi * 8;
    const bf16_t* Qr = QR + (rowbase + q0 + wid * QBLK + r32) * 512 + h * 64 + hi * 8;
#pragma unroll
    for (int d0 = 0; d0 < 8; ++d0) qr[d0] = *reinterpret_cast<const bf16x8*>(Qw + d0 * 16);
#pragma unroll
    for (int d0 = 0; d0 < 4; ++d0) qr[8 + d0] = *reinterpret_cast<const bf16x8*>(Qr + d0 * 16); }
  const bf16_t* Kh = KN + rowbase * 1024 + h * 128; const bf16_t* Vh = V + rowbase * 1024 + h * 128; const bf16_t* Krh = KR + rowbase * 64;
  const int sr = tid >> 4, sc = (tid & 15) * 8, vst0 = v_st(sr, sc), vst1 = v_st(32 + sr, sc);
  const int krr = tid >> 3, krc = (tid & 7) * 8;
  const int vb0 = (int)(uintptr_t)V_lds + v_rd_base(lane);
  bf16x8 vs0, vs1, ks0, ks1, kr0;
#define SLOAD_A(k0) do { vs0 = *reinterpret_cast<const bf16x8*>(&Vh[(long)((k0) + sr) * 1024 + sc]); vs1 = *reinterpret_cast<const bf16x8*>(&Vh[(long)((k0) + 32 + sr) * 1024 + sc]); } while (0)
#define SLOAD_R(k0) do { ks0 = *reinterpret_cast<const bf16x8*>(&Kh[(long)((k0) + sr) * 1024 + sc]); ks1 = *reinterpret_cast<const bf16x8*>(&Kh[(long)((k0) + 32 + sr) * 1024 + sc]); \
    kr0 = *reinterpret_cast<const bf16x8*>(&Krh[(long)((k0) + krr) * 64 + krc]); } while (0)
#define SLOAD(k0) do { SLOAD_A(k0); SLOAD_R(k0); } while (0)
#define SWRITE(bb) do { *(bf16x8*)(V_lds + (bb) * SHM_V + vst0) = vs0; *(bf16x8*)(V_lds + (bb) * SHM_V + vst1) = vs1; \
    *(bf16x8*)(Kn_lds + (bb) * SHM_KN + KSWZ(sr, sc * 2)) = ks0; *(bf16x8*)(Kn_lds + (bb) * SHM_KN + KSWZ(32 + sr, sc * 2)) = ks1; \
    *(bf16x8*)(Kr_lds + (bb) * SHM_KR + KRSWZ(krr, krc * 2)) = kr0; } while (0)
#define SWAIT() asm volatile("s_waitcnt vmcnt(0)" ::: "memory")
#define RESC(a) do { if (__any((a) < 1.f)) { if (hi == 0) al_l[r32] = (a); asm volatile("s_waitcnt lgkmcnt(0)" ::: "memory"); \
    _Pragma("unroll") for (int d = 0; d < 4; ++d) _Pragma("unroll") for (int r = 0; r < 16; ++r) o[d][r] *= al_l[crow(r, hi)]; } } while (0)
  f32x16 pA0, pA1, pB0, pB1; float mnA, mnB, alA, alB; bf16x8 pa0, pa1, pa2, pa3;
  SLOAD(0); SWAIT(); SWRITE(0); SLOAD(KVBLK); __syncthreads();
  qkt(pA0, pA1, Kn_lds, Kr_lds, qr, r32, hi, true); partialSM(pA0, pA1, m_reg, mnA, alA);
  SWAIT(); SWRITE(1); __syncthreads();
  for (int j = 1; j + 1 < NT; j += 2) {
    SBAR(); SLOAD_A((j + 1) * KVBLK); SBAR();
    qkt(pB0, pB1, Kn_lds + SHM_KN, Kr_lds + SHM_KR, qr, r32, hi, j < NTw);
    finishSM(pA0, pA1, alA, l_reg, pa0, pa1, pa2, pa3); SBAR();
    SLOAD_R((j + 1) * KVBLK); SBAR();
    pv_d0(o, vb0, pa0, pa1, pa2, pa3); partialSM(pB0, pB1, m_reg, mnB, alB);
    __syncthreads(); SWAIT(); SWRITE(0);
    RESC(alB); __syncthreads();
    SBAR(); SLOAD_A((j + 2) * KVBLK); SBAR();
    qkt(pA0, pA1, Kn_lds, Kr_lds, qr, r32, hi, j + 1 < NTw);
    finishSM(pB0, pB1, alB, l_reg, pa0, pa1, pa2, pa3); SBAR();
    SLOAD_R((j + 2) * KVBLK); SBAR();
    pv_d0(o, vb0 + SHM_V, pa0, pa1, pa2, pa3); partialSM(pA0, pA1, m_reg, mnA, alA);
    __syncthreads(); SWAIT(); SWRITE(1);
    RESC(alA); __syncthreads();
  }
  SBAR(); qkt(pB0, pB1, Kn_lds + SHM_KN, Kr_lds + SHM_KR, qr, r32, hi, NT - 1 < NTw);
  finishSM(pA0, pA1, alA, l_reg, pa0, pa1, pa2, pa3); SBAR();
  pv_d0(o, vb0, pa0, pa1, pa2, pa3); partialSM(pB0, pB1, m_reg, mnB, alB);
  __syncthreads(); RESC(alB);
  finishSM(pB0, pB1, alB, l_reg, pa0, pa1, pa2, pa3); SBAR();
  pv_d0(o, vb0 + SHM_V, pa0, pa1, pa2, pa3);
  if (hi == 0) li_l[r32] = l_reg; asm volatile("s_waitcnt lgkmcnt(0)" ::: "memory");
  float rli[16];
#pragma unroll
  for (int r = 0; r < 16; ++r) rli[r] = __builtin_amdgcn_rcpf(li_l[crow(r, hi)]);
  char* stg = lds + (wid < 2 ? wid * 8192 : 32768 + (wid - 2) * 8192);
#pragma unroll
  for (int r = 0; r < 16; ++r) { const int orow = crow(r, hi);
#pragma unroll
    for (int d0 = 0; d0 < 4; ++d0) { const float v = o[d0][r] * rli[r]; *(bf16_t*)(stg + orow * 256 + (d0 * 32 + r32) * 2) = (bf16_t)(cvtpk(v, v) & 0xffffu); } }
  asm volatile("s_waitcnt lgkmcnt(0)" ::: "memory");
  bf16_t* Ow = O + (rowbase + q0 + wid * QBLK) * 1024 + h * 128;
#pragma unroll
  for (int i = 0; i < 8; ++i) { const int chunk = i * 64 + lane, row = chunk >> 4, ch = chunk & 15;
    const u32x4 v = *(const u32x4*)(stg + row * 256 + ch * 16); *(u32x4*)(Ow + (long)row * 1024 + ch * 8) = v; }
  asm volatile("s_waitcnt lgkmcnt(0)" ::: "memory");
  __syncthreads();
#undef SLOAD
#undef SLOAD_A
#undef SLOAD_R
#undef SWRITE
#undef SWAIT
#undef RESC
}
#undef SBAR
}
typedef unsigned short bf16;
typedef unsigned v4u __attribute__((ext_vector_type(4)));
typedef unsigned v2u __attribute__((ext_vector_type(2)));
typedef float f32x4 __attribute__((ext_vector_type(4)));
#define LAS __attribute__((address_space(3)))
constexpr size_t MiB = 1u << 20;
#define XB_TMO      128
#define XB_XCNT(j)  (256  + 64 * (j))
#define XB_XSUB(j)  (1280 + 64 * (j))
#define XB_XGEN(j)  (2304 + 64 * (j))
#define XB_TOP      3328
#define XB_TOPGEN   3392
#define XCD_BAR_WORDS 3456
#define XB_SPIN_CAP (1u << 18)

__device__ __forceinline__ unsigned xb_ld(unsigned* p)              { return __hip_atomic_load(p, __ATOMIC_RELAXED, __HIP_MEMORY_SCOPE_AGENT); }
__device__ __forceinline__ unsigned xb_add(unsigned* p, unsigned v) { return __hip_atomic_fetch_add(p, v, __ATOMIC_RELAXED, __HIP_MEMORY_SCOPE_AGENT); }
__device__ __forceinline__ unsigned xb_xcc_id() { return (unsigned)__builtin_amdgcn_s_getreg((3 << 11) | 20) & 0xFu; }
#define XB_SPIN(cond, bar) do { unsigned _sp = 0; while (cond) { __builtin_amdgcn_s_sleep(1); \
    if ((++_sp & 255u) == 0u) { if (xb_ld(&(bar)[XB_TMO])) break; if (_sp > XB_SPIN_CAP) { atomicAdd(&(bar)[XB_TMO], 1u); break; } } } } while (0)

struct XcdBarrier {
    unsigned* bar; unsigned x;
    volatile LAS unsigned* st;
};

__device__ __forceinline__ XcdBarrier xcd_barrier_post(unsigned* bar, volatile LAS unsigned* st) {
    XcdBarrier b; b.bar = bar; b.x = xb_xcc_id(); b.st = st;
    if (threadIdx.x == 0) (void)xb_add(&bar[XB_XCNT(b.x)], 1u);
    return b;
}
__device__ __forceinline__ void xcd_barrier_complete(unsigned* bar, unsigned x, unsigned& nloc, unsigned& nx) {
    const unsigned G = gridDim.x * gridDim.y * gridDim.z;
    unsigned sum, cnt, mine, sp = 0u;
    for (;;) {
        sum = 0u; cnt = 0u; mine = 0u;
#pragma unroll
        for (unsigned j = 0; j < 16; ++j) { const unsigned c = xb_ld(&bar[XB_XCNT(j)]); sum += c; cnt += (c > 0u) ? 1u : 0u; mine = (j == x) ? c : mine; }
        if (sum == G) break;
        __builtin_amdgcn_s_sleep(1);
        if ((++sp & 255u) == 0u) { if (xb_ld(&bar[XB_TMO])) break; if (sp > XB_SPIN_CAP) { atomicAdd(&bar[XB_TMO], 1u); break; } }
    }
    nloc = mine > 0u ? mine : 1u; nx = cnt > 0u ? cnt : 1u;
}

__device__ __forceinline__ void xcd_barrier(const XcdBarrier& b) {
    asm volatile("s_waitcnt vmcnt(0)" ::: "memory");
    __syncthreads();
    if (threadIdx.x == 0) {
        unsigned* bar = b.bar;
        __builtin_amdgcn_s_waitcnt(0);
        unsigned nloc = b.st[0], nx = b.st[1];
        if (nloc == 0u) { xcd_barrier_complete(bar, b.x, nloc, nx); b.st[0] = nloc; b.st[1] = nx; }
        const unsigned old = xb_add(&bar[XB_XSUB(b.x)], 1u);
        const unsigned gen = old / nloc;
        if (old + 1u == (gen + 1u) * nloc) {
            __builtin_amdgcn_fence(__ATOMIC_RELEASE, "agent");
            asm volatile("s_waitcnt vmcnt(0)" ::: "memory");
            const unsigned og = xb_add(&bar[XB_TOP], 1u);
            const unsigned tg = og / nx;
            if (og + 1u == (tg + 1u) * nx) xb_add(&bar[XB_TOPGEN], 1u);
            else XB_SPIN(xb_ld(&bar[XB_TOPGEN]) == tg, bar);
            __builtin_amdgcn_fence(__ATOMIC_ACQUIRE, "agent");
            xb_add(&bar[XB_XGEN(b.x)], 1u);
            asm volatile("s_waitcnt vmcnt(0)" ::: "memory");
        } else {
            XB_SPIN(xb_ld(&bar[XB_XGEN(b.x)]) == gen, bar);
            __builtin_amdgcn_fence(__ATOMIC_ACQUIRE, "agent");
            asm volatile("s_waitcnt vmcnt(0)" ::: "memory");
        }
    }
    __syncthreads();
}

constexpr size_t WS_CTL = 0, CTL_ZERO_BYTES = 16384;
constexpr size_t WS_COS = 1 * MiB, WS_SIN = 5 * MiB, WS_W = 10 * MiB;
constexpr size_t WS_SSQ = 604 * MiB;
constexpr size_t WS_XN = 64 * MiB;
constexpr size_t WS_CONV = 128 * MiB;
constexpr size_t WS_Q = WS_CONV, WS_PB = WS_CONV, WS_PP = WS_CONV + 16 * MiB;
constexpr size_t WS_LORA = 224 * MiB;
constexpr size_t WS_QN = 272 * MiB;
constexpr size_t WS_KVN = 296 * MiB;
constexpr size_t WS_ATTN = 224 * MiB;
constexpr size_t WS_GATES = 312 * MiB;
constexpr size_t WS_YCB = 440 * MiB;
constexpr size_t WS_KROPE = 472 * MiB;
constexpr size_t WS_KNOPE = 476 * MiB;
constexpr size_t WS_V = 540 * MiB;
constexpr size_t WS_HB = WS_V;
constexpr size_t WS_HID = 312 * MiB;
constexpr size_t WS_LSSQ = 638 * MiB;
constexpr size_t WS_END = 642 * MiB;
constexpr size_t WO_GU1 = 0, WO_DN1 = WO_GU1 + (size_t)5632 * 1024 * 2, WO_IN = WO_DN1 + (size_t)1024 * 2816 * 2, WO_CO = WO_IN + (size_t)4352 * 1024 * 2,
    WO_UQ = WO_CO + (size_t)1024 * 512 * 2, WO_UKV = WO_UQ + (size_t)1536 * 384 * 2, WO_MO = WO_UKV + (size_t)2048 * 256 * 2, WO_WO = WO_MO + (size_t)1024 * 1024 * 2,
    WO_GU2 = WO_WO + (size_t)1024 * 1024 * 2, WO_DN2 = WO_GU2 + (size_t)5632 * 1024 * 2, WO_PG = WO_DN2 + (size_t)1024 * 2816 * 2, WO_PP = WO_PG + (size_t)1024 * 1024 * 2,
    WO_END = WO_PP + (size_t)1024 * 256 * 2;
static_assert(WS_W + WO_END <= WS_XN && WS_SSQ + 17 * (size_t)MTOK * 64 <= WS_END, "weights / ssq fit");

constexpr int NWAVES = 8, LDS_BYTES = 147456, RING_BYTES = 131072, MISC_OFF = RING_BYTES + 320;

struct Args { const float* in[23]; float* out; unsigned char* ws; };

__device__ __forceinline__ float wave_sum(float v) {
#pragma unroll
    for (int o = 1; o < 64; o <<= 1) v += __shfl_xor(v, o);
    return v;
}
__device__ __forceinline__ unsigned pk2(float lo, float hi) { return pg8::cvt_pk_bf16(lo, hi); }

template <int TYPE> __device__ __forceinline__ int map_src(int n) {
    if (TYPE == 0) return n;
    if (TYPE == 1) { const int pn = n >> 8, w = n & 255; return (w < 128) ? pn * 128 + w : 2816 + pn * 128 + (w - 128); }
    if (TYPE == 2) { if (n < 1536) return n; if (n < 3584) return n - 1536 + 2240; if (n < 4288) return n - 3584 + 1536; return -1; }
    if (TYPE == 3) { if (n < 1024) return (n >> 7) * 192 + (n & 127);
        const int m = n - 1024, head = m >> 6, w = m & 63, grp = w >> 5, within = w & 31, fqq = within >> 3, nn = (within >> 2) & 1, j = within & 3, i = grp * 16 + 4 * fqq + j;
        return head * 192 + 128 + (nn ? 32 : 0) + i; }
      { if (n < 1024) return (n >> 7) * 256 + (n & 127); const int m = n - 1024; return (m >> 7) * 256 + 128 + (m & 127); }
}
template <int TYPE, bool HASG, bool HALVE = false> __device__ __forceinline__ void cvt_item(const float* W, const float* gain, int K, int Nsrc, int Ndst, bf16* WT, LAS float* scr, int item, int lane) {
    const int nblk = Ndst / 64, kb = item / nblk, nb = item % nblk, k0 = 64 * kb, n0 = 64 * nb;
    const int n4 = (lane & 15) * 4, kq = lane >> 4;
    const int src = map_src<TYPE>(n0 + n4);
    const float* wp = W + (size_t)(k0 + kq) * Nsrc + (src >= 0 ? src : 0);
#pragma unroll 8
    for (int it = 0; it < 16; ++it) { const int kk = kq + 4 * it;
        f32x4 v = (src >= 0) ? __builtin_nontemporal_load((const f32x4*)(wp + (size_t)(4 * it) * Nsrc)) : (f32x4){0.f, 0.f, 0.f, 0.f};
        if (HASG) v = v * gain[k0 + kk]; if (HALVE) v = v * 0.5f;
        scr[kk * 64 + ((n4 + 0) ^ kk)] = v.x; scr[kk * 64 + ((n4 + 1) ^ kk)] = v.y; scr[kk * 64 + ((n4 + 2) ^ kk)] = v.z; scr[kk * 64 + ((n4 + 3) ^ kk)] = v.w; }
    asm volatile("s_waitcnt lgkmcnt(0)" ::: "memory");
    const int c = lane & 7;
#pragma unroll
    for (int j = 0; j < 8; ++j) { const int n = (lane >> 3) + 8 * j; float t[8];
#pragma unroll
        for (int i = 0; i < 8; ++i) t[i] = scr[(8 * c + i) * 64 + (n ^ (8 * c + i))];
        v4u o; o.x = pk2(t[0], t[1]); o.y = pk2(t[2], t[3]); o.z = pk2(t[4], t[5]); o.w = pk2(t[6], t[7]);
        *(v4u*)(WT + (size_t)(n0 + n) * K + k0 + 8 * c) = o; }
    asm volatile("s_waitcnt lgkmcnt(0)" ::: "memory");
}
__device__ __forceinline__ void x_row(const float* xrow, bf16* hbrow, float* ssq, int lane) {
    const f32x4* xr = (const f32x4*)xrow + lane;
    f32x4 v[4]; float s = 0.f;
#pragma unroll
    for (int j = 0; j < 4; ++j) { v[j] = xr[64 * j]; s += (v[j].x * v[j].x + v[j].y * v[j].y) + (v[j].z * v[j].z + v[j].w * v[j].w); }
    unsigned long long* o8 = (unsigned long long*)hbrow + lane;
#pragma unroll
    for (int j = 0; j < 4; ++j) o8[64 * j] = (unsigned long long)pk2(v[j].x, v[j].y) | ((unsigned long long)pk2(v[j].z, v[j].w) << 32);
    s = wave_sum(s);
    if (lane < 16) ssq[lane] = (lane == 0) ? s : 0.f;
}
#define CVT_WEIGHTS(LL, WANT_PG, WANT_REST) do                 { \
                    LAS float* scr = (LAS float*)((LAS unsigned char*)lds + wave * 16384); \
                    constexpr int I_GU = 16 * 88, I_DN = 44 * 16, I_IN = 16 * 68, I_CO = 8 * 16, I_UQ = 6 * 24, I_UKV = 4 * 32, I_SQ = 16 * 16, I_PP = 4 * 16; \
                    constexpr int NITEMS = 2 * I_GU + 2 * I_DN + I_IN + I_CO + I_UQ + I_UKV + 3 * I_SQ + I_PP; \
                    const size_t L = (size_t)(LL); \
                    for (int it = gw; it < NITEMS; it += NGW) { \
                        int r = it; \
                        if (r < I_GU) { if (WANT_REST) cvt_item<1, true>(INP(4) + L * 1024 * 5632, INP(3) + L * 1024, 1024, 5632, 5632, (bf16*)(WB + WO_GU1), scr, r, lane); continue; } r -= I_GU; \
                        if (r < I_GU) { if (WANT_REST) cvt_item<1, true>(INP(17) + L * 1024 * 5632, INP(16) + L * 1024, 1024, 5632, 5632, (bf16*)(WB + WO_GU2), scr, r, lane); continue; } r -= I_GU; \
                        if (r < I_DN) { if (WANT_REST) cvt_item<0, false, true>(INP(5) + L * 2816 * 1024, nullptr, 2816, 1024, 1024, (bf16*)(WB + WO_DN1), scr, r, lane); continue; } r -= I_DN; \
                        if (r < I_DN) { if (WANT_REST) cvt_item<0, false, true>(INP(18) + L * 2816 * 1024, nullptr, 2816, 1024, 1024, (bf16*)(WB + WO_DN2), scr, r, lane); continue; } r -= I_DN; \
                        if (r < I_IN) { if (WANT_REST) cvt_item<2, true>(INP(7) + L * 1024 * 4288, INP(6) + L * 1024, 1024, 4288, 4352, (bf16*)(WB + WO_IN), scr, r, lane); continue; } r -= I_IN; \
                        if (r < I_CO) { if (WANT_REST) cvt_item<0, false>(INP(9) + L * 512 * 1024, nullptr, 512, 1024, 1024, (bf16*)(WB + WO_CO), scr, r, lane); continue; } r -= I_CO; \
                        if (r < I_UQ) { if (WANT_REST) cvt_item<3, true>(INP(12) + L * 384 * 1536, INP(10) + L * 384, 384, 1536, 1536, (bf16*)(WB + WO_UQ), scr, r, lane); continue; } r -= I_UQ; \
                        if (r < I_UKV) { if (WANT_REST) cvt_item<4, true>(INP(13) + L * 256 * 2048, INP(11) + L * 256, 256, 2048, 2048, (bf16*)(WB + WO_UKV), scr, r, lane); continue; } r -= I_UKV; \
                        if (r < I_SQ) { if (WANT_REST) cvt_item<0, false>(INP(14) + L * 1024 * 1024, nullptr, 1024, 1024, 1024, (bf16*)(WB + WO_MO), scr, r, lane); continue; } r -= I_SQ; \
                        if (r < I_SQ) { if (WANT_REST) cvt_item<0, false>(INP(15) + L * 1024 * 1024, nullptr, 1024, 1024, 1024, (bf16*)(WB + WO_WO), scr, r, lane); continue; } r -= I_SQ; \
                        if (r < I_SQ) { if (WANT_PG) cvt_item<0, true>(INP(20) + L * 1024 * 1024, INP(19) + L * 1024, 1024, 1024, 1024, (bf16*)(WB + WO_PG), scr, r, lane); continue; } r -= I_SQ; \
                        if (WANT_REST) cvt_item<0, false>(INP(21) + L * 256 * 1024, nullptr, 256, 1024, 1024, (bf16*)(WB + WO_PP), scr, r, lane); \
                    } \
                } while (0)
__global__ void __launch_bounds__(NWAVES * 64, 2) mega_fwd(Args a) {
    extern __shared__ __attribute__((aligned(16))) unsigned char lds[];
    cg::grid_group grid = cg::this_grid();
    const int G = gridDim.x, bx = blockIdx.x, NGW = G * NWAVES;
    const int vcu = (G % 8 == 0) ? (bx % 8) * (G / 8) + bx / 8 : bx;
#define INP(k) ({ int _k = (k); asm volatile("" : "+s"(_k)); a.in[_k]; })
    float* h = a.out;

    for (int u = threadIdx.x; u < (LDS_BYTES - RING_BYTES) / 4; u += NWAVES * 64) ((LAS unsigned*)((LAS unsigned char*)lds + RING_BYTES))[u] = 0u;
    __syncthreads();
    const XcdBarrier bar = xcd_barrier_post((unsigned*)(a.ws + WS_CTL), (volatile LAS unsigned*)((LAS unsigned char*)lds + MISC_OFF) + 8);
    for (int layer = 0; layer < DEPTH; ++layer) {
        for (int step = 0; step < 12; ++step) {
    unsigned char* ws = a.ws; asm volatile("" : "+s"(ws));
    int tid_ = threadIdx.x; asm volatile("" : "+v"(tid_)); const int tid = tid_, lane = tid & 63, wave = __builtin_amdgcn_readfirstlane(tid >> 6), gw = bx * NWAVES + wave;
    float* cosT = (float*)(ws + WS_COS); float* sinT = (float*)(ws + WS_SIN); float* SSQ = (float*)(ws + WS_SSQ);
    bf16* XN = (bf16*)(ws + WS_XN); bf16* CONV = (bf16*)(ws + WS_CONV); bf16* QB = (bf16*)(ws + WS_Q); bf16* PB = (bf16*)(ws + WS_PB); bf16* PP = (bf16*)(ws + WS_PP);
    bf16* LORA = (bf16*)(ws + WS_LORA); bf16* QN = (bf16*)(ws + WS_QN); bf16* KVN = (bf16*)(ws + WS_KVN); bf16* ATT = (bf16*)(ws + WS_ATTN);
    bf16* GATES = (bf16*)(ws + WS_GATES); bf16* YCB = (bf16*)(ws + WS_YCB); bf16* KROPE = (bf16*)(ws + WS_KROPE); bf16* KNOPE = (bf16*)(ws + WS_KNOPE);
    bf16* QNP = (bf16*)((unsigned char*)h + (size_t)MTOK * DM * 2); bf16* QRP = (bf16*)(ws + WS_XN);     float* LSSQ = (float*)(ws + WS_LSSQ); bf16* VB = (bf16*)(ws + WS_V); bf16* HID = (bf16*)(ws + WS_HID); bf16* HB = (bf16*)h;     bf16* HB2 = XN;
    unsigned char* WB = ws + WS_W;
            if (step == 0 && layer > 0) {
                continue;
            } else if (step == 0) {
                CVT_WEIGHTS(layer, true, true);
                if (layer == 0) {
                    const int* pos = (const int*)INP(2);
                    for (int idx = bx * 512 + tid; idx < MTOK * 32; idx += G * 512) {
                        const int m = idx >> 5, i = idx & 31;
                        const float ang = (float)pos[m] * INV_FREQ[i];
                        double rev = (double)ang * 0.15915494309189535; rev -= __builtin_rint(rev);
                        const float rr = (float)(rev * 6.283185307179586);
                        cosT[idx] = __cosf(rr); sinT[idx] = __sinf(rr);
                    }
                    const float* x = INP(0);
                    for (int m = gw; m < MTOK; m += NGW) x_row(x + (size_t)m * DM, HB2 + (size_t)m * DM, SSQ + (size_t)m * 16, lane);
                }
            } else if (step == 4) {
                continue;
            } else if (step == 6) {
                for (int i = 0; i < 1024; ++i) {
                    const int idx = i * G + vcu; if (idx >= 1024) break;
                    const int c = idx & 255, rnd = idx >> 8, bh = c >> 2, s = c & 3;
                    const int qb = (rnd == 0) ? 15 - s : (rnd == 1) ? 11 - s : (rnd == 2) ? 4 + s : s;
                    att::attn_unit(bh >> 3, bh & 7, qb, QNP, QRP, KNOPE, KROPE, VB, ATT, (char*)lds);
                }
            } else {
                if (step == 11 && layer + 1 < DEPTH) { CVT_WEIGHTS(layer + 1, false, true); __syncthreads(); }
                if (step == 1 && layer > 0) { CVT_WEIGHTS(layer, true, false); __syncthreads(); }
                if (step == 5) {
                const float* cw = INP(8) + layer * 3 * 512;
                const int c0 = lane * 8;
                f32x4 w0a = *(const f32x4*)(cw + c0), w0b = *(const f32x4*)(cw + c0 + 4), w1a = *(const f32x4*)(cw + 512 + c0), w1b = *(const f32x4*)(cw + 512 + c0 + 4),
                      w2a = *(const f32x4*)(cw + 1024 + c0), w2b = *(const f32x4*)(cw + 1024 + c0 + 4);
#pragma unroll 4
                for (int m = gw; m < MTOK; m += NGW) {
                    const int t = m & (SEQ - 1);
                    const bf16* cr = CONV + (size_t)m * 1536;
                    f32x4 ya, yb;
                    { f32x4 ca, cb, va, vb; pg8::unpack8(*(const v4u*)(cr + 512 + c0), ca, cb); pg8::unpack8(*(const v4u*)(cr + 1024 + c0), va, vb); ya = w2a * (ca * va); yb = w2b * (cb * vb); }
                    if (t >= 1) { f32x4 ca, cb, va, vb; pg8::unpack8(*(const v4u*)(cr - 1536 + 512 + c0), ca, cb); pg8::unpack8(*(const v4u*)(cr - 1536 + 1024 + c0), va, vb); ya += w1a * (ca * va); yb += w1b * (cb * vb); }
                    if (t >= 2) { f32x4 ca, cb, va, vb; pg8::unpack8(*(const v4u*)(cr - 3072 + 512 + c0), ca, cb); pg8::unpack8(*(const v4u*)(cr - 3072 + 1024 + c0), va, vb); ya += w0a * (ca * va); yb += w0b * (cb * vb); }
                    { f32x4 ba, bb; pg8::unpack8(*(const v4u*)(cr + c0), ba, bb); *(v4u*)(YCB + (size_t)m * 512 + c0) = pg8::pack8(ba * ya, bb * yb); }
                    const bf16* lr = LORA + (size_t)m * 768;
                    if (lane < 32) { const float x1 = pg8::bf_lo((unsigned)lr[640 + lane]), x2 = pg8::bf_lo((unsigned)lr[672 + lane]);
                      const float c = cosT[(size_t)m * 32 + lane], s = sinT[(size_t)m * 32 + lane];
                      KROPE[(size_t)m * 64 + lane] = (bf16)(pk2(x1 * c - x2 * s, 0.f) & 0xffffu); KROPE[(size_t)m * 64 + 32 + lane] = (bf16)(pk2(x2 * c + x1 * s, 0.f) & 0xffffu); }
                }
                }
                if (step == 8) {
                    const float* p = INP(1) + (size_t)layer * MTOK * 256;
                    for (int idx = bx * 512 + tid; idx < MTOK * 256 / 8; idx += G * 512) {
                        const f32x4 x0 = *(const f32x4*)(p + (size_t)idx * 8), x1 = *(const f32x4*)(p + (size_t)idx * 8 + 4);
                        v4u o; o.x = pk2(x0.x, x0.y); o.y = pk2(x0.z, x0.w); o.z = pk2(x1.x, x1.y); o.w = pk2(x1.z, x1.w);
                        *(v4u*)(PB + (size_t)idx * 8) = o;
                    }
                }
                const int ng = (step == 5 || step == 7 || step == 9) ? 2 : 1;
                constexpr size_t SQA = (size_t)MTOK * 16; float* sq0 = SSQ + (size_t)(layer * 4) * SQA;
                for (int gi = 0; gi < ng; ++gi) {
                    pg8::Gemm g; g.M = MTOK; g.lda = 0; pg8::Epi E{}; int sq_off = 0, sq_n4 = 4, sq_stride = 16; float sq_inv = 1.f / DM; E.h = h; E.cosT = cosT; E.sinT = sinT; E.scale = 1.f; E.hb = HB; E.rl = (LAS float*)((LAS unsigned char*)lds + RING_BYTES + 1024);
                    if (step == 1) { g.A = HB2; g.Bt = (const bf16*)(WB + WO_GU1); g.N = 5632; g.K = 1024; E.mode = pg8::EPI_GU; E.o0 = HID; E.ssq_in = sq0; }
                    else if (step == 9 && gi == 0) { g.A = HB; g.Bt = (const bf16*)(WB + WO_GU2); g.N = 5632; g.K = 1024; E.mode = pg8::EPI_GU; E.o0 = HID; E.ssq_in = sq0 + 2 * SQA; }
                    else if (step == 2 || step == 10) { g.A = HID; g.Bt = (const bf16*)(WB + (step == 2 ? WO_DN1 : WO_DN2)); g.N = 1024; g.K = 2816; E.mode = pg8::EPI_RES; E.ssq_out = sq0 + (step == 2 ? 1 : 3) * SQA; E.hsrc = (step == 2) ? HB2 : HB; }
                    else if (step == 3) { g.A = HB; g.Bt = (const bf16*)(WB + WO_IN); g.N = 4352; g.K = 1024; E.mode = pg8::EPI_SPLIT; E.o0 = CONV; E.ld0 = 1536; E.t1 = 6; E.o1 = GATES; E.ld1 = 2048; E.t2 = 14; E.sig1 = 1; E.o2 = LORA; E.ld2 = 768; E.ssq_in = sq0 + SQA; E.lssq = LSSQ; }
                    else if (step == 5 && gi == 0) { g.A = LORA; g.lda = 768; g.Bt = (const bf16*)(WB + WO_UQ); g.N = 1536; g.K = 384; E.mode = pg8::EPI_UQ; E.o0 = QNP; E.o1 = QRP; E.ssq_in = LSSQ; sq_off = 0; sq_n4 = 3; sq_stride = 32; sq_inv = 1.f / 384.f; }
                    else if (step == 5) { g.A = LORA + 384; g.lda = 768; E.ssq_in = LSSQ; sq_off = 12; sq_n4 = 2; sq_stride = 32; sq_inv = 1.f / 256.f; g.Bt = (const bf16*)(WB + WO_UKV); g.N = 2048; g.K = 256; E.mode = pg8::EPI_SPLIT; E.o0 = KNOPE; E.ld0 = 1024; E.t1 = 4; E.o1 = VB; E.ld1 = 1024; E.t2 = 1000; E.o2 = VB; E.ld2 = 1024; }
                    else if (step == 7 && gi == 0) { g.A = ATT; g.Bt = (const bf16*)(WB + WO_MO); g.N = 1024; g.K = 1024; E.mode = pg8::EPI_MO; E.o0 = XN; E.g = GATES; }
                    else if (step == 7) { g.A = YCB; g.Bt = (const bf16*)(WB + WO_CO); g.N = 1024; g.K = 512; E.mode = pg8::EPI_CO; E.o0 = XN; E.g = GATES; }
                    else if (step == 8) { g.A = XN; g.Bt = (const bf16*)(WB + WO_WO); g.N = 1024; g.K = 1024; E.mode = pg8::EPI_RES; E.scale = 1.f; E.ssq_out = sq0 + 2 * SQA; E.hsrc = HB; }
                    else if (step == 9) { g.A = PB; g.Bt = (const bf16*)(WB + WO_PP); g.N = 1024; g.K = 256; E.mode = pg8::EPI_SPLIT; E.o0 = PP; E.ld0 = 1024; E.t1 = 1000; E.t2 = 1000; E.o1 = PP; E.o2 = PP; E.ld1 = 1024; E.ld2 = 1024; }
                    else { g.A = HB; g.Bt = (const bf16*)(WB + WO_PG); g.N = 1024; g.K = 1024; E.mode = pg8::EPI_PLE; E.g = PP; E.ssq_in = sq0 + 3 * SQA; E.ssq_out = sq0 + 4 * SQA; E.hb2 = HB2; }
                    pg8::StaticOrder S; S.init(g.M, g.N, G, bx);
                    if (g.lda == 0) g.lda = g.K;
                    if (E.ssq_in) {
                        pg8::Unit uu;
                        for (int i = 0; S.next(i, uu); ++i)
                            if (tid < 256) { const f32x4* sp = (const f32x4*)(E.ssq_in + (size_t)(uu.pm * 256 + tid) * sq_stride + sq_off); f32x4 s4 = sp[0];
                                for (int q4 = 1; q4 < sq_n4; ++q4) s4 += sp[q4];
                                E.rl[i * 256 + tid] = 1.0f / sqrtf(((s4[0] + s4[1]) + (s4[2] + s4[3])) * sq_inv + EPS); }
                        __syncthreads();
                    }
                    pg8::gemm_phase<pg8::Epi, pg8::StaticOrder, true, true>((LAS unsigned char*)lds, g, S, E);
                }
            }
            if (a.ws == nullptr) grid.sync();     xcd_barrier(bar);
        }
    }
    { const float* gain = INP(22); const int tid = threadIdx.x, lane = tid & 63, wave = __builtin_amdgcn_readfirstlane(tid >> 6), gw = bx * NWAVES + wave;
      const bf16* HB2 = (const bf16*)(a.ws + WS_XN);
      for (int m = gw; m < MTOK; m += NGW) {
          const v4u* xr = (const v4u*)(HB2 + (size_t)m * DM) + lane * 2; f32x4 v[4];
          pg8::unpack8(xr[0], v[0], v[1]); pg8::unpack8(xr[1], v[2], v[3]);
          float s = 0.f;
#pragma unroll
          for (int j = 0; j < 4; ++j) s += (v[j].x * v[j].x + v[j].y * v[j].y) + (v[j].z * v[j].z + v[j].w * v[j].w);
          const float r = 1.0f / sqrtf(wave_sum(s) * (1.f / DM) + EPS);
          const f32x4* gr = (const f32x4*)gain + lane * 4; f32x4* orow = (f32x4*)(h + (size_t)m * DM) + lane * 4;
#pragma unroll
          for (int j = 0; j < 4; ++j) orow[j] = v[j] * r * gr[j];
      } }
}

extern "C" void kernel_launch(void* const* d_in, const int* in_sizes, int n_in, void* d_out, int out_size, void* d_ws, size_t ws_size, hipStream_t stream) {
    static int grid = 0;
    if (grid == 0) {
        if (n_in != 23 || out_size != MTOK * DM || ws_size < WS_END) { fprintf(stderr, "kernel_launch: unexpected shapes: n_in %d out %d ws %zu (need %zu)\n", n_in, out_size, ws_size, (size_t)WS_END); grid = -1; return; }
        int dev = 0, cus = 0, per_cu = 0;
        if (hipGetDevice(&dev) != hipSuccess || hipDeviceGetAttribute(&cus, hipDeviceAttributeMultiprocessorCount, dev) != hipSuccess) { grid = -1; return; }
        if (hipFuncSetAttribute((const void*)mega_fwd, hipFuncAttributeMaxDynamicSharedMemorySize, LDS_BYTES) != hipSuccess) { fprintf(stderr, "kernel_launch: hipFuncSetAttribute failed\n"); grid = -1; return; }
        if (hipOccupancyMaxActiveBlocksPerMultiprocessor(&per_cu, (const void*)mega_fwd, NWAVES * 64, LDS_BYTES) != hipSuccess || per_cu < 1) { fprintf(stderr, "kernel_launch: occupancy query says %d\n", per_cu); per_cu = 1; }
        (void)hipGetLastError();
        grid = cus * per_cu;
    }
    if (grid < 0) return;
    if (hipMemsetAsync((char*)d_ws + WS_CTL, 0, CTL_ZERO_BYTES, stream) != hipSuccess) { fprintf(stderr, "kernel_launch: memset failed\n"); return; }
    Args a{};
    for (int i = 0; i < 23; ++i) a.in[i] = (const float*)d_in[i];
    a.out = (float*)d_out; a.ws = (unsigned char*)d_ws;
    void* args[] = {&a};
    hipError_t e = hipLaunchCooperativeKernel((const void*)mega_fwd, dim3(grid), dim3(NWAVES * 64), args, LDS_BYTES, stream);
    if (e != hipSuccess) fprintf(stderr, "cooperative launch failed: %s (grid %d)\n", hipGetErrorString(e), grid);
}
```

```cpp
#include <hip/hip_runtime.h>
#include <hip/hip_cooperative_groups.h>
#include <cstdio>
#include <cstdint>
namespace cg = cooperative_groups;

constexpr int MTOK = 32768, DM = 1024, DFF = 2816, SEQ = 4096, DEPTH = 4;
constexpr float EPS = 1e-6f;
__constant__ float INV_FREQ[32] = {
 0x1.0000000000000p+0f, 0x1.7ff2220000000p-1f, 0x1.1feb340000000p-1f, 0x1.afd1360000000p-2f, 0x1.43d1360000000p-2f, 0x1.e5a8480000000p-3f, 0x1.6c310e0000000p-3f, 0x1.111aee0000000p-3f,
 0x1.99999a0000000p-4f, 0x1.33281c0000000p-4f, 0x1.ccab860000000p-5f, 0x1.59742a0000000p-5f, 0x1.030dc40000000p-5f, 0x1.8486a00000000p-6f, 0x1.235a720000000p-6f, 0x1.b4f7e20000000p-7f,
 0x1.47ae140000000p-7f, 0x1.eb73600000000p-8f, 0x1.7089380000000p-8f, 0x1.145cee0000000p-8f, 0x1.9e7c6e0000000p-9f, 0x1.36d21a0000000p-9f, 0x1.d22a500000000p-10f, 0x1.5d931c0000000p-10f,
 0x1.0624de0000000p-10f, 0x1.8929180000000p-11f, 0x1.26d42c0000000p-11f, 0x1.ba2e4c0000000p-12f, 0x1.4b96be0000000p-12f, 0x1.f150280000000p-13f, 0x1.74eea60000000p-13f, 0x1.17a8e40000000p-13f};

namespace pg8 {
#define PG8_LAS __attribute__((address_space(3)))
typedef unsigned short bf16_t;
typedef short bf16x8 __attribute__((ext_vector_type(8)));
typedef float f32x4 __attribute__((ext_vector_type(4)));
typedef unsigned u32x4 __attribute__((ext_vector_type(4)));
constexpr int BM = 256, BK = 64, HALF = 128, HTB = HALF * BK * 2  , STAGE_BYTES = 8 * HTB, NXCD = 8, WGM = 8;

__host__ __device__ __forceinline__ int lds_byte(int r, int c) { const int st = (r >> 4) * 2 + (c >> 5), rr = r & 15, cc = c & 31, ob = rr * 64 + cc * 2; return st * 1024 + (ob ^ (((ob >> 9) & 1) << 5)); }
__host__ __device__ __forceinline__ void stage_rc(int b, int& R, int& C) { const int st = b / 1024, sb = b % 1024, swz = sb ^ (((sb >> 9) & 1) << 5); R = (st >> 1) * 16 + swz / 64; C = (st & 1) * 32 + (swz % 64) / 2; }
__host__ __device__ __forceinline__ int perm32(int rho) { const int n = rho >> 4, i = rho & 15; return 8 * (i >> 2) + 4 * n + (i & 3); }

struct Unit { int pm, pn; };
struct Gemm { const bf16_t* A; const bf16_t* Bt; int M, N, K, lda; };

struct StaticOrder {
    int nM, nN, nwg, G, c;
    __host__ __device__ void init(int M, int N, int G_, int c_) { nM = M / BM; nN = N / BM; nwg = nM * nN; G = G_; c = c_; }
    __host__ __device__ bool next(int i, Unit& u) const {
        const long L = (long)i * G + c; if (L >= nwg) return false;
        int wgid = (int)L; { const int q = nwg / NXCD, r = nwg % NXCD, xcd = wgid % NXCD, off = wgid / NXCD; wgid = (xcd < r ? xcd * (q + 1) : r * (q + 1) + (xcd - r) * q) + off; }
        const int nig = WGM * nN, gid = wgid / nig, fm = gid * WGM, gsz = (nM - fm) < WGM ? (nM - fm) : WGM;
        u.pm = fm + ((wgid % nig) % gsz); u.pn = (wgid % nig) / gsz; return true;
    }
    __device__ __forceinline__ void a_ready(const Unit&) const {}
    __device__ __forceinline__ void done(const Unit&) const {}
};

typedef unsigned u32x2 __attribute__((ext_vector_type(2)));
typedef _Float16 h16x8 __attribute__((ext_vector_type(8)));
__device__ __forceinline__ unsigned cvt_pk_bf16(float lo, float hi) { unsigned r; asm volatile("v_cvt_pk_bf16_f32 %0, %1, %2" : "=v"(r) : "v"(lo), "v"(hi)); return r; }
__device__ __forceinline__ float sigm(float x) { return __builtin_amdgcn_rcpf(1.f + __builtin_amdgcn_exp2f(-1.4426950408889634f * x)); }
__device__ __forceinline__ float bf_lo(unsigned w) { return __builtin_bit_cast(float, w << 16); }
__device__ __forceinline__ float bf_hi(unsigned w) { return __builtin_bit_cast(float, w & 0xffff0000u); }
__device__ __forceinline__ u32x4 pack8(const f32x4& a, const f32x4& b) { u32x4 w; w.x = cvt_pk_bf16(a[0], a[1]); w.y = cvt_pk_bf16(a[2], a[3]); w.z = cvt_pk_bf16(b[0], b[1]); w.w = cvt_pk_bf16(b[2], b[3]); return w; }
__device__ __forceinline__ void unpack8(const u32x4& w, f32x4& a, f32x4& b) { a[0] = bf_lo(w.x); a[1] = bf_hi(w.x); a[2] = bf_lo(w.y); a[3] = bf_hi(w.y); b[0] = bf_lo(w.z); b[1] = bf_hi(w.z); b[2] = bf_lo(w.w); b[3] = bf_hi(w.w); }

enum { EPI_GU = 0, EPI_RES = 1, EPI_SPLIT = 2, EPI_UQ = 3, EPI_MO = 4, EPI_CO = 5, EPI_PLE = 6 };
struct Epi {
    int mode; float scale;
    float* h;
    bf16_t* o0; bf16_t* o1; bf16_t* o2; int ld0, ld1, ld2, t1, t2, sig1;
    const bf16_t* g;
    const float* cosT; const float* sinT;
    const float* ssq_in; float* ssq_out; bf16_t* hb; bf16_t* hb2; const bf16_t* hsrc; float* lssq; PG8_LAS float* rl;
    mutable int ui;
    __device__ __forceinline__ void init_acc(f32x4 (&acc)[2][2][4][2], const Unit& u, int wr, int wc, int fr, int fq) const {
        if (mode == EPI_RES) {
            const bf16_t* base = hsrc + (size_t)(u.pm * BM + wr * 64 + fr) * DM + u.pn * BM + wc * 32 + 8 * fq;
            u32x4 t[2][4][2];
#pragma unroll
            for (int ai = 0; ai < 2; ++ai)
#pragma unroll
                for (int m = 0; m < 4; ++m)
#pragma unroll
                    for (int bj = 0; bj < 2; ++bj) t[ai][m][bj] = *(const u32x4*)(base + (size_t)(ai * HALF + m * 16) * DM + bj * HALF);
#pragma unroll
            for (int ai = 0; ai < 2; ++ai)
#pragma unroll
                for (int m = 0; m < 4; ++m)
#pragma unroll
                    for (int bj = 0; bj < 2; ++bj) unpack8(t[ai][m][bj], acc[ai][bj][m][0], acc[ai][bj][m][1]);
        } else {
#pragma unroll
            for (int ai = 0; ai < 2; ++ai)
#pragma unroll
                for (int bj = 0; bj < 2; ++bj)
#pragma unroll
                    for (int m = 0; m < 4; ++m) { acc[ai][bj][m][0] = (f32x4){0.f, 0.f, 0.f, 0.f}; acc[ai][bj][m][1] = (f32x4){0.f, 0.f, 0.f, 0.f}; }
        }
    }
    __device__ __forceinline__ void operator()(f32x4 (&acc)[2][2][4][2], const Unit& u, int wr, int wc, int fr, int fq) const {
        const int row0 = u.pm * BM + wr * 64 + fr;
        float rs[2][4];
        if (ssq_in) {
#pragma unroll
            for (int ai = 0; ai < 2; ++ai)
#pragma unroll
                for (int m = 0; m < 4; ++m) rs[ai][m] = rl[ui * BM + wr * 64 + ai * HALF + m * 16 + fr];
        } else {
#pragma unroll
            for (int ai = 0; ai < 2; ++ai)
#pragma unroll
                for (int m = 0; m < 4; ++m) rs[ai][m] = 1.f;
        }
        ++ui;
        if (mode == EPI_GU) {
            const int col = u.pn * 128 + wc * 32 + 8 * fq;
#pragma unroll
            for (int ai = 0; ai < 2; ++ai)
#pragma unroll
                for (int m = 0; m < 4; ++m) { f32x4 r0, r1;
#pragma unroll
                    for (int j = 0; j < 4; ++j) { const float g0 = acc[ai][0][m][0][j] * rs[ai][m], g1 = acc[ai][0][m][1][j] * rs[ai][m]; r0[j] = g0 * sigm(g0) * (acc[ai][1][m][0][j] * rs[ai][m]); r1[j] = g1 * sigm(g1) * (acc[ai][1][m][1][j] * rs[ai][m]); }
                    *(u32x4*)(o0 + (size_t)(row0 + ai * HALF + m * 16) * DFF + col) = pack8(r0, r1); }
        } else if (mode == EPI_RES) {
#pragma unroll
            for (int ai = 0; ai < 2; ++ai)
#pragma unroll
                for (int m = 0; m < 4; ++m) { const size_t row = (size_t)(row0 + ai * HALF + m * 16); const int col = u.pn * BM + wc * 32 + 8 * fq; float sq = 0.f;
#pragma unroll
                    for (int bj = 0; bj < 2; ++bj) { const f32x4 a = acc[ai][bj][m][0], b = acc[ai][bj][m][1];
                        *(u32x4*)(hb + row * DM + col + bj * HALF) = pack8(a, b);
                        sq += (a[0] * a[0] + a[1] * a[1]) + (a[2] * a[2] + a[3] * a[3]) + (b[0] * b[0] + b[1] * b[1]) + (b[2] * b[2] + b[3] * b[3]); }
                    sq += __shfl_xor(sq, 16); sq += __shfl_xor(sq, 32);
                    if (fq == 0) ssq_out[row * 16 + u.pn * 4 + wc] = sq;
                    }
        } else if (mode == EPI_SPLIT) {
            bf16_t* base; int ld, colt; bool sg = false;
            if (u.pn < t1) { base = o0; ld = ld0; colt = u.pn * BM; } else if (u.pn < t2) { base = o1; ld = ld1; colt = (u.pn - t1) * BM; sg = sig1 != 0; } else { base = o2; ld = ld2; colt = (u.pn - t2) * BM; }
#pragma unroll
            for (int ai = 0; ai < 2; ++ai)
#pragma unroll
                for (int m = 0; m < 4; ++m) { bf16_t* rowp = base + (size_t)(row0 + ai * HALF + m * 16) * ld + colt + wc * 32 + 8 * fq;
#pragma unroll
                    for (int bj = 0; bj < 2; ++bj) { f32x4 a = acc[ai][bj][m][0] * rs[ai][m], b = acc[ai][bj][m][1] * rs[ai][m];
                        if (sg) {
#pragma unroll
                            for (int j = 0; j < 4; ++j) { a[j] = sigm(a[j]); b[j] = sigm(b[j]); } }
                        *(u32x4*)(rowp + bj * HALF) = pack8(a, b);
                        if (lssq && u.pn >= t2) {
                            float sq = (a[0] * a[0] + a[1] * a[1]) + (a[2] * a[2] + a[3] * a[3]) + (b[0] * b[0] + b[1] * b[1]) + (b[2] * b[2] + b[3] * b[3]);
                            sq += __shfl_xor(sq, 16); sq += __shfl_xor(sq, 32);
                            if (fq == 0) lssq[(size_t)(row0 + ai * HALF + m * 16) * 32 + (u.pn - t2) * 8 + bj * 4 + wc] = sq; } } }
        } else if (mode == EPI_UQ) {
            if (u.pn < 4) {
#pragma unroll
                for (int ai = 0; ai < 2; ++ai)
#pragma unroll
                    for (int m = 0; m < 4; ++m) { bf16_t* rowp = o0 + (size_t)(row0 + ai * HALF + m * 16) * 1024 + u.pn * BM + wc * 32 + 8 * fq;
#pragma unroll
                        for (int bj = 0; bj < 2; ++bj) *(u32x4*)(rowp + bj * HALF) = pack8(acc[ai][bj][m][0] * rs[ai][m], acc[ai][bj][m][1] * rs[ai][m]); }
            } else {
                const int i0 = (wc & 1) * 16 + 4 * fq;
#pragma unroll
                for (int ai = 0; ai < 2; ++ai)
#pragma unroll
                    for (int m = 0; m < 4; ++m) { const int row = row0 + ai * HALF + m * 16;
                        const f32x4 cs = *(const f32x4*)(cosT + (size_t)row * 32 + i0), sn = *(const f32x4*)(sinT + (size_t)row * 32 + i0);
#pragma unroll
                        for (int bj = 0; bj < 2; ++bj) { const int head = (u.pn - 4) * 4 + 2 * bj + (wc >> 1);
                            const f32x4 x1 = acc[ai][bj][m][0] * rs[ai][m], x2 = acc[ai][bj][m][1] * rs[ai][m]; const f32x4 y1 = x1 * cs - x2 * sn, y2 = x2 * cs + x1 * sn;
                            bf16_t* p = o1 + (size_t)row * 512 + head * 64 + i0;
                            u32x2 w1, w2; w1.x = cvt_pk_bf16(y1[0], y1[1]); w1.y = cvt_pk_bf16(y1[2], y1[3]); w2.x = cvt_pk_bf16(y2[0], y2[1]); w2.y = cvt_pk_bf16(y2[2], y2[3]);
                            *(u32x2*)p = w1; *(u32x2*)(p + 32) = w2; } }
            }
        } else if (mode == EPI_MO || mode == EPI_CO) {
            const int goff = (mode == EPI_MO) ? 1024 : 0;
#pragma unroll
            for (int ai = 0; ai < 2; ++ai)
#pragma unroll
                for (int m = 0; m < 4; ++m) { const size_t row = (size_t)(row0 + ai * HALF + m * 16); const int col = u.pn * BM + wc * 32 + 8 * fq;
#pragma unroll
                    for (int bj = 0; bj < 2; ++bj) { f32x4 ga, gb; unpack8(*(const u32x4*)(g + row * 2048 + goff + col + bj * HALF), ga, gb);
                        f32x4 a = ga * acc[ai][bj][m][0], b = gb * acc[ai][bj][m][1];
                        bf16_t* p = o0 + row * DM + col + bj * HALF;
                        if (mode == EPI_CO) { f32x4 pa, pb; unpack8(*(const u32x4*)p, pa, pb); a += pa; b += pb; }
                        *(u32x4*)p = pack8(a, b); } }
        } else {
#pragma unroll
            for (int ai = 0; ai < 2; ++ai)
#pragma unroll
                for (int m = 0; m < 4; ++m) { const size_t row = (size_t)(row0 + ai * HALF + m * 16); const int col = u.pn * BM + wc * 32 + 8 * fq; float sq = 0.f;
#pragma unroll
                    for (int bj = 0; bj < 2; ++bj) { f32x4 pa, pb, a, b; unpack8(*(const u32x4*)(g + row * DM + col + bj * HALF), pa, pb); unpack8(*(const u32x4*)(hb + row * DM + col + bj * HALF), a, b);
#pragma unroll
                        for (int j = 0; j < 4; ++j) { a[j] += sigm(acc[ai][bj][m][0][j] * rs[ai][m]) * pa[j]; b[j] += sigm(acc[ai][bj][m][1][j] * rs[ai][m]) * pb[j]; }
                        *(u32x4*)(hb2 + row * DM + col + bj * HALF) = pack8(a, b);
                        sq += (a[0] * a[0] + a[1] * a[1]) + (a[2] * a[2] + a[3] * a[3]) + (b[0] * b[0] + b[1] * b[1]) + (b[2] * b[2] + b[3] * b[3]); }
                    sq += __shfl_xor(sq, 16); sq += __shfl_xor(sq, 32);
                    if (fq == 0) ssq_out[row * 16 + u.pn * 4 + wc] = sq;
                    }
        }
    }
};
template <class Epi, class Sched, bool ALIGN_EPI = false, bool SP2 = false>
__device__ __forceinline__ void gemm_phase(PG8_LAS unsigned char* lds, const Gemm g, const Sched& S, const Epi& E) {
    int tid_ = threadIdx.x; asm volatile("" : "+v"(tid_)); const int tid = tid_, wid = __builtin_amdgcn_readfirstlane(tid >> 6), lane = tid & 63, wr = wid >> 2, wc = wid & 3, fr = lane & 15, fq = lane >> 4;
    const int K = g.K, nt = K / BK;
    unsigned voffA[2], voffB[2];
#pragma unroll
    for (int i = 0; i < 2; ++i) { int R, C; stage_rc(tid * 16 + i * 8192, R, C); const int Rb = true ? ((R & ~31) + perm32(R & 31)) : R;
        voffA[i] = (unsigned)(R * g.lda + C) * 2u; voffB[i] = (unsigned)(Rb * K + C) * 2u; }
    const size_t kstep = (size_t)(BK * 2);
    const size_t hstepA = (size_t)HALF * g.lda * 2, hstep = (size_t)HALF * K * 2;
    const size_t tstepA = 2 * hstepA, tstep = 2 * hstep;
    const unsigned ldsw = (unsigned)wid * 1024u;
    const int aoff = lds_byte(wr * 64 + fr, fq * 8), boff = lds_byte(wc * 32 + fr, fq * 8);
#define PG8_SA(b, h) (((b) * 2 + (h)) * HTB)
#define PG8_SB(b, h) ((4 + (b) * 2 + (h)) * HTB)
#define PG8_STAGE(bufoff, gbase, voff) do { _Pragma("unroll") for (int _i = 0; _i < 2; ++_i) \
        __builtin_amdgcn_global_load_lds((const unsigned*)((const char*)(gbase) + (voff)[_i]), (PG8_LAS unsigned*)(lds + (bufoff) + ldsw + _i * 8192), 16, 0, 0); } while (0)
#define PG8_LDA(dst, b, h) do { _Pragma("unroll") for (int m = 0; m < 4; ++m) _Pragma("unroll") for (int k = 0; k < 2; ++k) dst[m][k] = *(const PG8_LAS bf16x8*)(lds + PG8_SA(b, h) + aoff + m * 2048 + k * 1024); } while (0)
#define PG8_LDB(dst, b, h) do { _Pragma("unroll") for (int n = 0; n < 2; ++n) _Pragma("unroll") for (int k = 0; k < 2; ++k) dst[n][k] = *(const PG8_LAS bf16x8*)(lds + PG8_SB(b, h) + boff + n * 2048 + k * 1024); } while (0)
#define PG8_MMA(ai, bj, At, Bt) do { __builtin_amdgcn_s_setprio(1); _Pragma("unroll") for (int m = 0; m < 4; ++m) _Pragma("unroll") for (int n = 0; n < 2; ++n) _Pragma("unroll") for (int k = 0; k < 2; ++k) \
        acc[ai][bj][m][n] = __builtin_amdgcn_mfma_f32_16x16x32_bf16(Bt[n][k], At[m][k], acc[ai][bj][m][n], 0, 0, 0); __builtin_amdgcn_s_setprio(0); } while (0)
#define PG8_WAIT_V(n) asm volatile("s_waitcnt vmcnt(" #n ")" ::: "memory")
#define PG8_WAIT_L(n) asm volatile("s_waitcnt lgkmcnt(" #n ")" ::: "memory")
#define PG8_BAR __builtin_amdgcn_s_barrier()
#define PG8_SCHED __builtin_amdgcn_sched_barrier(0)
    Unit cur, nxt; int ui = 0;
    if (!S.next(0, cur)) return;
    f32x4 acc[2][2][4][2];
    E.init_acc(acc, cur, wr, wc, fr, fq);
    bf16x8 At[4][2], B0[2][2], B1[2][2];
    const char* cA = (const char*)g.A + (size_t)cur.pm * tstepA; const char* cB = (const char*)g.Bt + (size_t)cur.pn * tstep;
    S.a_ready(cur);
    if constexpr (SP2) {
        PG8_STAGE(PG8_SB(0, 0), cB, voffB); PG8_STAGE(PG8_SB(0, 1), cB + hstep, voffB); PG8_STAGE(PG8_SA(0, 0), cA, voffA); PG8_STAGE(PG8_SA(0, 1), cA + hstepA, voffA);
        if (wr == 1) PG8_BAR;
        PG8_WAIT_V(2); PG8_BAR;
        PG8_STAGE(PG8_SB(1, 0), cB + kstep, voffB); PG8_STAGE(PG8_SA(1, 0), cA + kstep, voffA); PG8_STAGE(PG8_SB(1, 1), cB + hstep + kstep, voffB);
        PG8_WAIT_V(6); PG8_BAR;
    } else {
        PG8_STAGE(PG8_SB(0, 0), cB, voffB); PG8_STAGE(PG8_SA(0, 0), cA, voffA); PG8_STAGE(PG8_SB(0, 1), cB + hstep, voffB); PG8_STAGE(PG8_SA(0, 1), cA + hstepA, voffA);
        if (wr == 1) PG8_BAR;
        PG8_WAIT_V(4); PG8_BAR;
        PG8_STAGE(PG8_SB(1, 0), cB + kstep, voffB); PG8_STAGE(PG8_SA(1, 0), cA + kstep, voffA); PG8_STAGE(PG8_SB(1, 1), cB + hstep + kstep, voffB);
        PG8_WAIT_V(6); PG8_BAR;
    }
    for (;;) {
        const bool has_next = S.next(ui + 1, nxt);
        const char* nA = has_next ? (const char*)g.A + (size_t)nxt.pm * tstepA : cA; const char* nB = has_next ? (const char*)g.Bt + (size_t)nxt.pn * tstep : cB;
        for (int t = 0; t < nt; t += 2) {
            const bool last = (t == nt - 2);
            const char* a1 = cA + (size_t)(t + 1) * kstep;
            const char* a2 = last ? nA : cA + (size_t)(t + 2) * kstep; const char* b2 = last ? nB : cB + (size_t)(t + 2) * kstep;
            const char* a3 = a2 + kstep; const char* b3 = b2 + kstep;
            if (last && has_next) S.a_ready(nxt);
            if constexpr (SP2) {
            PG8_LDB(B0, 0, 0); PG8_LDB(B1, 0, 1); PG8_SCHED; PG8_LDA(At, 0, 0); PG8_STAGE(PG8_SA(1, 1), a1 + hstepA, voffA);
            PG8_WAIT_V(8); PG8_WAIT_L(0); PG8_BAR; PG8_MMA(0, 0, At, B0); PG8_MMA(0, 1, At, B1); PG8_BAR; PG8_SCHED;
            PG8_LDA(At, 0, 1); PG8_STAGE(PG8_SB(0, 0), b2, voffB); PG8_STAGE(PG8_SB(0, 1), b2 + hstep, voffB); PG8_STAGE(PG8_SA(0, 0), a2, voffA);
            PG8_WAIT_V(8); PG8_WAIT_L(0); PG8_BAR; PG8_MMA(1, 0, At, B0); PG8_MMA(1, 1, At, B1); PG8_BAR; PG8_SCHED;
            PG8_LDB(B0, 1, 0); PG8_LDB(B1, 1, 1); PG8_SCHED; PG8_LDA(At, 1, 0); PG8_STAGE(PG8_SA(0, 1), a2 + hstepA, voffA);
            PG8_WAIT_V(8); PG8_WAIT_L(0); PG8_BAR; PG8_MMA(0, 0, At, B0); PG8_MMA(0, 1, At, B1); PG8_BAR; PG8_SCHED;
            PG8_LDA(At, 1, 1); PG8_STAGE(PG8_SB(1, 0), b3, voffB); PG8_STAGE(PG8_SB(1, 1), b3 + hstep, voffB); PG8_STAGE(PG8_SA(1, 0), a3, voffA);
            PG8_WAIT_V(8); PG8_WAIT_L(0); PG8_BAR; PG8_MMA(1, 0, At, B0); PG8_MMA(1, 1, At, B1); PG8_BAR; PG8_SCHED;
            } else {
            PG8_LDB(B0, 0, 0); PG8_SCHED; PG8_LDA(At, 0, 0); PG8_STAGE(PG8_SA(1, 1), a1 + hstepA, voffA);
            PG8_WAIT_L(8); PG8_BAR; PG8_WAIT_L(0); PG8_MMA(0, 0, At, B0); PG8_BAR; PG8_SCHED;
            PG8_LDB(B1, 0, 1); PG8_STAGE(PG8_SB(0, 0), b2, voffB);
            PG8_BAR; PG8_WAIT_L(0); PG8_MMA(0, 1, At, B1); PG8_BAR;
            PG8_LDA(At, 0, 1); PG8_STAGE(PG8_SA(0, 0), a2, voffA);
            PG8_BAR; PG8_WAIT_L(0); PG8_MMA(1, 0, At, B0); PG8_BAR; PG8_SCHED;
            PG8_STAGE(PG8_SB(0, 1), b2 + hstep, voffB);
            PG8_WAIT_V(6); PG8_BAR; PG8_MMA(1, 1, At, B1); PG8_BAR;
            PG8_LDB(B0, 1, 0); PG8_SCHED; PG8_LDA(At, 1, 0); PG8_STAGE(PG8_SA(0, 1), a2 + hstepA, voffA);
            PG8_WAIT_L(8); PG8_BAR; PG8_WAIT_L(0); PG8_MMA(0, 0, At, B0); PG8_BAR; PG8_SCHED;
            PG8_LDB(B1, 1, 1); PG8_STAGE(PG8_SB(1, 0), b3, voffB);
            PG8_BAR; PG8_WAIT_L(0); PG8_MMA(0, 1, At, B1); PG8_BAR;
            PG8_LDA(At, 1, 1); PG8_STAGE(PG8_SA(1, 0), a3, voffA);
            PG8_BAR; PG8_WAIT_L(0); PG8_MMA(1, 0, At, B0); PG8_BAR; PG8_SCHED;
            PG8_STAGE(PG8_SB(1, 1), b3 + hstep, voffB);
            PG8_WAIT_V(6); PG8_BAR; PG8_MMA(1, 1, At, B1); PG8_BAR;
            }
        }
        if constexpr (ALIGN_EPI) { if (wr == 0) PG8_BAR; }
        if constexpr (!false) { E(acc, cur, wr, wc, fr, fq); S.done(cur); }
        if (!has_next) break;
        E.init_acc(acc, nxt, wr, wc, fr, fq);
        cur = nxt; cA = nA; cB = nB; ++ui;
        if constexpr (ALIGN_EPI) { if (wr == 1) PG8_BAR; }
    }
    PG8_WAIT_V(0);
    if constexpr (!ALIGN_EPI) { if (wr == 0) PG8_BAR; }
    PG8_BAR;
    if constexpr (false) { E.fused(acc, cur, wr, wc, fr, fq, lds, wid, lane); S.done(cur); }
#undef PG8_SA
#undef PG8_SB
#undef PG8_STAGE
#undef PG8_LDA
#undef PG8_LDB
#undef PG8_MMA
#undef PG8_WAIT_V
#undef PG8_WAIT_L
#undef PG8_BAR
#undef PG8_SCHED
}
}
namespace att {
using bf16x8 = __attribute__((ext_vector_type(8))) short;
using s16x4  = __attribute__((ext_vector_type(4))) short;
using f32x16 = __attribute__((ext_vector_type(16))) float;
using u32x4  = __attribute__((ext_vector_type(4))) unsigned;
typedef unsigned short bf16_t;
constexpr int NW = 8, QBLK = 32, KVBLK = 64;
constexpr float SCALE = 0.07216878364870322f;
constexpr float THR = 8.f;
constexpr int SHM_V = 16384, SHM_KN = 16384, SHM_KR = 8192;
constexpr int OFF_V = 0, OFF_KN = 2 * SHM_V, OFF_KR = OFF_KN + 2 * SHM_KN, OFF_WS = OFF_KR + 2 * SHM_KR, LDS_BYTES = OFF_WS + NW * 64 * 4;
#define KSWZ(row, colB) ((row) * 256 + ((colB) ^ (((row) & 7) << 4)))
#define KRSWZ(row, colB) ((row) * 128 + ((colB) ^ ((((row) >> 1) & 7) << 4)))
#define SBAR() __builtin_amdgcn_sched_barrier(0)
__device__ __forceinline__ int crow(int r, int hi) { return (r & 3) + 8 * (r >> 2) + 4 * hi; }
__device__ __forceinline__ unsigned cvtpk(float lo, float hi) { unsigned r; asm volatile("v_cvt_pk_bf16_f32 %0, %1, %2" : "=v"(r) : "v"(lo), "v"(hi)); return r; }

__device__ __forceinline__ void partialSM(f32x16& p0, f32x16& p1, float& m_reg, float& mn, float& alpha) {
  constexpr float C = SCALE * 1.4426950408889634f;
  float pmax = p0[0];
#pragma unroll
  for (int r = 1; r < 16; ++r) pmax = fmaxf(pmax, p0[r]);
#pragma unroll
  for (int r = 0; r < 16; ++r) pmax = fmaxf(pmax, p1[r]);
  { auto rr = __builtin_amdgcn_permlane32_swap(__float_as_uint(pmax), __float_as_uint(pmax), false, false);
    pmax = fmaxf(__uint_as_float(rr[0]), __uint_as_float(rr[1])); }
  if (__builtin_expect(__all(pmax - m_reg <= THR / SCALE), 1)) { mn = m_reg; alpha = 1.f; }
  else { mn = fmaxf(m_reg, pmax); alpha = __builtin_amdgcn_exp2f((m_reg - mn) * C); m_reg = mn; }
  float mnC = -mn * C;
#pragma unroll
  for (int r = 0; r < 16; ++r) p0[r] = fmaf(p0[r], C, mnC);
#pragma unroll
  for (int r = 0; r < 16; ++r) p1[r] = fmaf(p1[r], C, mnC);
#pragma unroll
  for (int r = 0; r < 16; ++r) p0[r] = __builtin_amdgcn_exp2f(p0[r]);
}
__device__ __forceinline__ void finishSM(f32x16& p0, f32x16& p1, float alpha, float& l_reg, bf16x8& pa0, bf16x8& pa1, bf16x8& pa2, bf16x8& pa3) {
#pragma unroll
  for (int r = 0; r < 16; ++r) p1[r] = __builtin_amdgcn_exp2f(p1[r]);
  float ps = 0;
#pragma unroll
  for (int r = 0; r < 16; ++r) ps += p0[r];
#pragma unroll
  for (int r = 0; r < 16; ++r) ps += p1[r];
  { auto rr = __builtin_amdgcn_permlane32_swap(__float_as_uint(ps), __float_as_uint(ps), false, false);
    ps = __uint_as_float(rr[0]) + __uint_as_float(rr[1]); }
  l_reg = l_reg * alpha + ps;
#define PK4(P, BASE, OUT) do { unsigned a0 = cvtpk(P[BASE + 0], P[BASE + 1]), a1 = cvtpk(P[BASE + 2], P[BASE + 3]);   \
    unsigned b0 = cvtpk(P[BASE + 4], P[BASE + 5]), b1 = cvtpk(P[BASE + 6], P[BASE + 7]);                              \
    auto r0 = __builtin_amdgcn_permlane32_swap(a0, b0, false, false); auto r1 = __builtin_amdgcn_permlane32_swap(a1, b1, false, false); \
    u32x4 w = {r0[0], r1[0], r0[1], r1[1]}; OUT = *reinterpret_cast<bf16x8*>(&w); } while (0)
  PK4(p0, 0, pa0); PK4(p0, 8, pa1); PK4(p1, 0, pa2); PK4(p1, 8, pa3);
#undef PK4
}
__device__ __forceinline__ void qkt(f32x16& p0, f32x16& p1, const char* Kn, const char* Kr, const bf16x8* qr, int r32, int hi, bool live) {
  if (live) {
    p0 = f32x16{}; p1 = f32x16{};
#pragma unroll
    for (int d0 = 0; d0 < 8; ++d0) { const int cb = (d0 * 16 + hi * 8) * 2;
      bf16x8 b0 = *reinterpret_cast<const bf16x8*>(Kn + KSWZ(r32, cb));
      bf16x8 b1 = *reinterpret_cast<const bf16x8*>(Kn + KSWZ(32 + r32, cb));
      p0 = __builtin_amdgcn_mfma_f32_32x32x16_bf16(b0, qr[d0], p0, 0, 0, 0);
      p1 = __builtin_amdgcn_mfma_f32_32x32x16_bf16(b1, qr[d0], p1, 0, 0, 0); }
#pragma unroll
    for (int d0 = 0; d0 < 4; ++d0) { const int cb = (d0 * 16 + hi * 8) * 2;
      bf16x8 b0 = *reinterpret_cast<const bf16x8*>(Kr + KRSWZ(r32, cb));
      bf16x8 b1 = *reinterpret_cast<const bf16x8*>(Kr + KRSWZ(32 + r32, cb));
      p0 = __builtin_amdgcn_mfma_f32_32x32x16_bf16(b0, qr[8 + d0], p0, 0, 0, 0);
      p1 = __builtin_amdgcn_mfma_f32_32x32x16_bf16(b1, qr[8 + d0], p1, 0, 0, 0); }
  } else {
#pragma unroll
    for (int r = 0; r < 16; ++r) { p0[r] = -1e30f; p1[r] = -1e30f; }
  }
}
__device__ __forceinline__ int v_st(int k, int c) { const int kk = (k & ~0xC) | ((k & 4) << 1) | ((k & 8) >> 1); return ((kk >> 3) * 4 + (c >> 5)) * 512 + ((kk & 7) * 32 + (c & 31)) * 2; }
__device__ __forceinline__ int v_rd_base(int lane) { return ((lane & 3) << 3) | (((lane >> 2) & 3) << 6) | (((lane >> 4) & 1) << 5) | (((lane >> 5) & 1) << 8); }
constexpr int v_rd_off(int d0, int ks, int half) { return d0 * 512 + ks * 4096 + half * 2048; }
template <int OFF> __device__ __forceinline__ s16x4 tr_read(int vb) {
  s16x4 r; asm volatile("ds_read_b64_tr_b16 %0, %1 offset:%2" : "=&v"(r) : "v"(vb), "i"(OFF) : "memory"); return r;
}
template <int D0> __device__ __forceinline__ void pv_one(f32x16& od, int vb, bf16x8 pa0, bf16x8 pa1, bf16x8 pa2, bf16x8 pa3) {
  const s16x4 l0 = tr_read<v_rd_off(D0, 0, 0)>(vb), h0 = tr_read<v_rd_off(D0, 0, 1)>(vb), l1 = tr_read<v_rd_off(D0, 1, 0)>(vb), h1 = tr_read<v_rd_off(D0, 1, 1)>(vb);
  const s16x4 l2 = tr_read<v_rd_off(D0, 2, 0)>(vb), h2 = tr_read<v_rd_off(D0, 2, 1)>(vb), l3 = tr_read<v_rd_off(D0, 3, 0)>(vb), h3 = tr_read<v_rd_off(D0, 3, 1)>(vb);
  asm volatile("s_waitcnt lgkmcnt(0)" ::: "memory"); SBAR();
#define PK(L, H) (bf16x8){L[0], L[1], L[2], L[3], H[0], H[1], H[2], H[3]}
  od = __builtin_amdgcn_mfma_f32_32x32x16_bf16(pa0, PK(l0, h0), od, 0, 0, 0);
  od = __builtin_amdgcn_mfma_f32_32x32x16_bf16(pa1, PK(l1, h1), od, 0, 0, 0);
  od = __builtin_amdgcn_mfma_f32_32x32x16_bf16(pa2, PK(l2, h2), od, 0, 0, 0);
  od = __builtin_amdgcn_mfma_f32_32x32x16_bf16(pa3, PK(l3, h3), od, 0, 0, 0);
#undef PK
}
__device__ __forceinline__ void pv_d0(f32x16* o, int vb, bf16x8 pa0, bf16x8 pa1, bf16x8 pa2, bf16x8 pa3) {
  pv_one<0>(o[0], vb, pa0, pa1, pa2, pa3); pv_one<1>(o[1], vb, pa0, pa1, pa2, pa3); pv_one<2>(o[2], vb, pa0, pa1, pa2, pa3); pv_one<3>(o[3], vb, pa0, pa1, pa2, pa3);
}

__device__ __forceinline__ void attn_unit(int b, int h, int qb, const bf16_t* __restrict__ Q, const bf16_t* __restrict__ QR, const bf16_t* __restrict__ KN, const bf16_t* __restrict__ KR, const bf16_t* __restrict__ V, bf16_t* __restrict__ O, char* lds) {
  int tid_ = threadIdx.x; asm volatile("" : "+v"(tid_)); const int tid = tid_, wid = __builtin_amdgcn_readfirstlane(tid >> 6), lane = tid & 63, r32 = lane & 31, hi = lane >> 5;
  char* V_lds = lds + OFF_V; char* Kn_lds = lds + OFF_KN; char* Kr_lds = lds + OFF_KR;
  float* ws = (float*)(lds + OFF_WS) + wid * 64; float* li_l = ws; float* al_l = ws + 32;
  const long rowbase = (long)b * SEQ; const int q0 = qb * 256;
  const int NT = (q0 + 256) / KVBLK;
  const int NTw = q0 / KVBLK + (wid >> 1) + 1;
  float m_reg = -1e30f, l_reg = 0; f32x16 o[4] = {}; bf16x8 qr[12];
  { const bf16_t* Qw = Q + (rowbase + q0 + wid * QBLK + r32) * 1024 + h * 128 + hi * 8;
    const bf16_t* Qr = QR + (rowbase + q0 + wid * QBLK + r32) * 512 + h * 64 + hi * 8;
#pragma unroll
    for (int d0 = 0; d0 < 8; ++d0) qr[d0] = *reinterpret_cast<const bf16x8*>(Qw + d0 * 16);
#pragma unroll
    for (int d0 = 0; d0 < 4; ++d0) qr[8 + d0] = *reinterpret_cast<const bf16x8*>(Qr + d0 * 16); }
  const bf16_t* Kh = KN + rowbase * 1024 + h * 128; const bf16_t* Vh = V + rowbase * 1024 + h * 128; const bf16_t* Krh = KR + rowbase * 64;
  const int sr = tid >> 4, sc = (tid & 15) * 8, vst0 = v_st(sr, sc), vst1 = v_st(32 + sr, sc);
  const int krr = tid >> 3, krc = (tid & 7) * 8;
  const int vb0 = (int)(uintptr_t)V_lds + v_rd_base(lane);
  bf16x8 vs0, vs1, ks0, ks1, kr0;
#define SLOAD_A(k0) do { vs0 = *reinterpret_cast<const bf16x8*>(&Vh[(long)((k0) + sr) * 1024 + sc]); vs1 = *reinterpret_cast<const bf16x8*>(&Vh[(long)((k0) + 32 + sr) * 1024 + sc]); } while (0)
#define SLOAD_R(k0) do { ks0 = *reinterpret_cast<const bf16x8*>(&Kh[(long)((k0) + sr) * 1024 + sc]); ks1 = *reinterpret_cast<const bf16x8*>(&Kh[(long)((k0) + 32 + sr) * 1024 + sc]); \
    kr0 = *reinterpret_cast<const bf16x8*>(&Krh[(long)((k0) + krr) * 64 + krc]); } while (0)
#define SLOAD(k0) do { SLOAD_A(k0); SLOAD_R(k0); } while (0)
#define SWRITE(bb) do { *(bf16x8*)(V_lds + (bb) * SHM_V + vst0) = vs0; *(bf16x8*)(V_lds + (bb) * SHM_V + vst1) = vs1; \
    *(bf16x8*)(Kn_lds + (bb) * SHM_KN + KSWZ(sr, sc * 2)) = ks0; *(bf16x8*)(Kn_lds + (bb) * SHM_KN + KSWZ(32 + sr, sc * 2)) = ks1; \
    *(bf16x8*)(Kr_lds + (bb) * SHM_KR + KRSWZ(krr, krc * 2)) = kr0; } while (0)
#define SWAIT() asm volatile("s_waitcnt vmcnt(0)" ::: "memory")
#define RESC(a) do { if (__any((a) < 1.f)) { if (hi == 0) al_l[r32] = (a); asm volatile("s_waitcnt lgkmcnt(0)" ::: "memory"); \
    _Pragma("unroll") for (int d = 0; d < 4; ++d) _Pragma("unroll") for (int r = 0; r < 16; ++r) o[d][r] *= al_l[crow(r, hi)]; } } while (0)
  f32x16 pA0, pA1, pB0, pB1; float mnA, mnB, alA, alB; bf16x8 pa0, pa1, pa2, pa3;
  SLOAD(0); SWAIT(); SWRITE(0); SLOAD(KVBLK); __syncthreads();
  qkt(pA0, pA1, Kn_lds, Kr_lds, qr, r32, hi, true); partialSM(pA0, pA1, m_reg, mnA, alA);
  SWAIT(); SWRITE(1); __syncthreads();
  for (int j = 1; j + 1 < NT; j += 2) {
    SBAR(); SLOAD_A((j + 1) * KVBLK); SBAR();
    qkt(pB0, pB1, Kn_lds + SHM_KN, Kr_lds + SHM_KR, qr, r32, hi, j < NTw);
    finishSM(pA0, pA1, alA, l_reg, pa0, pa1, pa2, pa3); SBAR();
    SLOAD_R((j + 1) * KVBLK); SBAR();
    pv_d0(o, vb0, pa0, pa1, pa2, pa3); partialSM(pB0, pB1, m_reg, mnB, alB);
    __syncthreads(); SWAIT(); SWRITE(0);
    RESC(alB); __syncthreads();
    SBAR(); SLOAD_A((j + 2) * KVBLK); SBAR();
    qkt(pA0, pA1, Kn_lds, Kr_lds, qr, r32, hi, j + 1 < NTw);
    finishSM(pB0, pB1, alB, l_reg, pa0, pa1, pa2, pa3); SBAR();
    SLOAD_R((j + 2) * KVBLK); SBAR();
    pv_d0(o, vb0 + SHM_V, pa0, pa1, pa2, pa3); partialSM(pA0, pA1, m_reg, mnA, alA);
    __syncthreads(); SWAIT(); SWRITE(1);
    RESC(alA); __syncthreads();
  }
  SBAR(); qkt(pB0, pB1, Kn_lds + SHM_KN, Kr_lds + SHM_KR, qr, r32, hi, NT - 1 < NTw);
  finishSM(pA0, pA1, alA, l_reg, pa0, pa1, pa2, pa3); SBAR();
  pv_d0(o, vb0, pa0, pa1, pa2, pa3); partialSM(pB0, pB1, m_reg, mnB, alB);
  __syncthreads(); RESC(alB);
  finishSM(pB0, pB1, alB, l_reg, pa0, pa1, pa2, pa3); SBAR();
  pv_d0(o, vb0 + SHM_V, pa0, pa1, pa2, pa3);
  if (hi == 0) li_l[r32] = l_reg; asm volatile("s_waitcnt lgkmcnt(0)" ::: "memory");
  float rli[16];
#pragma unroll
  for (int r = 0; r < 16; ++r) rli[r] = __builtin_amdgcn_rcpf(li_l[crow(r, hi)]);
  char* stg = lds + (wid < 2 ? wid * 8192 : 32768 + (wid - 2) * 8192);
#pragma unroll
  for (int r = 0; r < 16; ++r) { const int orow = crow(r, hi);
#pragma unroll
    for (int d0 = 0; d0 < 4; ++d0) { const float v = o[d0][r] * rli[r]; *(bf16_t*)(stg + orow * 256 + (d0 * 32 + r32) * 2) = (bf16_t)(cvtpk(v, v) & 0xffffu); } }
  asm volatile("s_waitcnt lgkmcnt(0)" ::: "memory");
  bf16_t* Ow = O + (rowbase + q0 + wid * QBLK) * 1024 + h * 128;
#pragma unroll
  for (int i = 0; i < 8; ++i) { const int chunk = i * 64 + lane, row = chunk >> 4, ch = chunk & 15;
    const u32x4 v = *(const u32x4*)(stg + row * 256 + ch * 16); *(u32x4*)(Ow + (long)row * 1024 + ch * 8) = v; }
  asm volatile("s_waitcnt lgkmcnt(0)" ::: "memory");
  __syncthreads();
#undef SLOAD
#undef SLOAD_A
#undef SLOAD_R
#undef SWRITE
#undef SWAIT
#undef RESC
}
#undef SBAR
}
typedef unsigned short bf16;
typedef unsigned v4u __attribute__((ext_vector_type(4)));
typedef unsigned v2u __attribute__((ext_vector_type(2)));
typedef float f32x4 __attribute__((ext_vector_type(4)));
#define LAS __attribute__((address_space(3)))
constexpr size_t MiB = 1u << 20;
#define XB_TMO      128
#define XB_XCNT(j)  (256  + 64 * (j))
#define XB_XSUB(j)  (1280 + 64 * (j))
#define XB_XGEN(j)  (2304 + 64 * (j))
#define XB_TOP      3328
#define XB_TOPGEN   3392
#define XCD_BAR_WORDS 3456
#define XB_SPIN_CAP (1u << 18)

__device__ __forceinline__ unsigned xb_ld(unsigned* p)              { return __hip_atomic_load(p, __ATOMIC_RELAXED, __HIP_MEMORY_SCOPE_AGENT); }
__device__ __forceinline__ unsigned xb_add(unsigned* p, unsigned v) { return __hip_atomic_fetch_add(p, v, __ATOMIC_RELAXED, __HIP_MEMORY_SCOPE_AGENT); }
__device__ __forceinline__ unsigned xb_xcc_id() { return (unsigned)__builtin_amdgcn_s_getreg((3 << 11) | 20) & 0xFu; }
#define XB_SPIN(cond, bar) do { unsigned _sp = 0; while (cond) { __builtin_amdgcn_s_sleep(1); \
    if ((++_sp & 255u) == 0u) { if (xb_ld(&(bar)[XB_TMO])) break; if (_sp > XB_SPIN_CAP) { atomicAdd(&(bar)[XB_TMO], 1u); break; } } } } while (0)

struct XcdBarrier {
    unsigned* bar; unsigned x;
    volatile LAS unsigned* st;
};

__device__ __forceinline__ XcdBarrier xcd_barrier_post(unsigned* bar, volatile LAS unsigned* st) {
    XcdBarrier b; b.bar = bar; b.x = xb_xcc_id(); b.st = st;
    if (threadIdx.x == 0) (void)xb_add(&bar[XB_XCNT(b.x)], 1u);
    return b;
}
__device__ __forceinline__ void xcd_barrier_complete(unsigned* bar, unsigned x, unsigned& nloc, unsigned& nx) {
    const unsigned G = gridDim.x * gridDim.y * gridDim.z;
    unsigned sum, cnt, mine, sp = 0u;
    for (;;) {
        sum = 0u; cnt = 0u; mine = 0u;
#pragma unroll
        for (unsigned j = 0; j < 16; ++j) { const unsigned c = xb_ld(&bar[XB_XCNT(j)]); sum += c; cnt += (c > 0u) ? 1u : 0u; mine = (j == x) ? c : mine; }
        if (sum == G) break;
        __builtin_amdgcn_s_sleep(1);
        if ((++sp & 255u) == 0u) { if (xb_ld(&bar[XB_TMO])) break; if (sp > XB_SPIN_CAP) { atomicAdd(&bar[XB_TMO], 1u); break; } }
    }
    nloc = mine > 0u ? mine : 1u; nx = cnt > 0u ? cnt : 1u;
}

__device__ __forceinline__ void xcd_barrier(const XcdBarrier& b) {
    asm volatile("s_waitcnt vmcnt(0)" ::: "memory");
    __syncthreads();
    if (threadIdx.x == 0) {
        unsigned* bar = b.bar;
        __builtin_amdgcn_s_waitcnt(0);
        unsigned nloc = b.st[0], nx = b.st[1];
        if (nloc == 0u) { xcd_barrier_complete(bar, b.x, nloc, nx); b.st[0] = nloc; b.st[1] = nx; }
        const unsigned old = xb_add(&bar[XB_XSUB(b.x)], 1u);
        const unsigned gen = old / nloc;
        if (old + 1u == (gen + 1u) * nloc) {
            __builtin_amdgcn_fence(__ATOMIC_RELEASE, "agent");
            asm volatile("s_waitcnt vmcnt(0)" ::: "memory");
            const unsigned og = xb_add(&bar[XB_TOP], 1u);
            const unsigned tg = og / nx;
            if (og + 1u == (tg + 1u) * nx) xb_add(&bar[XB_TOPGEN], 1u);
            else XB_SPIN(xb_ld(&bar[XB_TOPGEN]) == tg, bar);
            __builtin_amdgcn_fence(__ATOMIC_ACQUIRE, "agent");
            xb_add(&bar[XB_XGEN(b.x)], 1u);
            asm volatile("s_waitcnt vmcnt(0)" ::: "memory");
        } else {
            XB_SPIN(xb_ld(&bar[XB_XGEN(b.x)]) == gen, bar);
            __builtin_amdgcn_fence(__ATOMIC_ACQUIRE, "agent");
            asm volatile("s_waitcnt vmcnt(0)" ::: "memory");
        }
    }
    __syncthreads();
}

constexpr size_t WS_CTL = 0, CTL_ZERO_BYTES = 16384;
constexpr size_t WS_COS = 1 * MiB, WS_SIN = 5 * MiB, WS_W = 10 * MiB;
constexpr size_t WS_SSQ = 604 * MiB;
constexpr size_t WS_XN = 64 * MiB;
constexpr size_t WS_CONV = 128 * MiB;
constexpr size_t WS_Q = WS_CONV, WS_PB = WS_CONV, WS_PP = WS_CONV + 16 * MiB;
constexpr size_t WS_LORA = 224 * MiB;
constexpr size_t WS_QN = 272 * MiB;
constexpr size_t WS_KVN = 296 * MiB;
constexpr size_t WS_ATTN = 224 * MiB;
constexpr size_t WS_GATES = 312 * MiB;
constexpr size_t WS_YCB = 440 * MiB;
constexpr size_t WS_KROPE = 472 * MiB;
constexpr size_t WS_KNOPE = 476 * MiB;
constexpr size_t WS_V = 540 * MiB;
constexpr size_t WS_HB = WS_V;
constexpr size_t WS_HID = 312 * MiB;
constexpr size_t WS_LSSQ = 638 * MiB;
constexpr size_t WS_END = 642 * MiB;
constexpr size_t WO_GU1 = 0, WO_DN1 = WO_GU1 + (size_t)5632 * 1024 * 2, WO_IN = WO_DN1 + (size_t)1024 * 2816 * 2, WO_CO = WO_IN + (size_t)4352 * 1024 * 2,
    WO_UQ = WO_CO + (size_t)1024 * 512 * 2, WO_UKV = WO_UQ + (size_t)1536 * 384 * 2, WO_MO = WO_UKV + (size_t)2048 * 256 * 2, WO_WO = WO_MO + (size_t)1024 * 1024 * 2,
    WO_GU2 = WO_WO + (size_t)1024 * 1024 * 2, WO_DN2 = WO_GU2 + (size_t)5632 * 1024 * 2, WO_PG = WO_DN2 + (size_t)1024 * 2816 * 2, WO_PP = WO_PG + (size_t)1024 * 1024 * 2,
    WO_END = WO_PP + (size_t)1024 * 256 * 2;
static_assert(WS_W + WO_END <= WS_XN && WS_SSQ + 17 * (size_t)MTOK * 64 <= WS_END, "weights / ssq fit");

constexpr int NWAVES = 8, LDS_BYTES = 147456, RING_BYTES = 131072, MISC_OFF = RING_BYTES + 320;

struct Args { const float* in[23]; float* out; unsigned char* ws; };

__device__ __forceinline__ float wave_sum(float v) {
#pragma unroll
    for (int o = 1; o < 64; o <<= 1) v += __shfl_xor(v, o);
    return v;
}
__device__ __forceinline__ unsigned pk2(float lo, float hi) { return pg8::cvt_pk_bf16(lo, hi); }

template <int TYPE> __device__ __forceinline__ int map_src(int n) {
    if (TYPE == 0) return n;
    if (TYPE == 1) { const int pn = n >> 8, w = n & 255; return (w < 128) ? pn * 128 + w : 2816 + pn * 128 + (w - 128); }
    if (TYPE == 2) { if (n < 1536) return n; if (n < 3584) return n - 1536 + 2240; if (n < 4288) return n - 3584 + 1536; return -1; }
    if (TYPE == 3) { if (n < 1024) return (n >> 7) * 192 + (n & 127);
        const int m = n - 1024, head = m >> 6, w = m & 63, grp = w >> 5, within = w & 31, fqq = within >> 3, nn = (within >> 2) & 1, j = within & 3, i = grp * 16 + 4 * fqq + j;
        return head * 192 + 128 + (nn ? 32 : 0) + i; }
      { if (n < 1024) return (n >> 7) * 256 + (n & 127); const int m = n - 1024; return (m >> 7) * 256 + 128 + (m & 127); }
}
template <int TYPE, bool HASG, bool HALVE = false> __device__ __forceinline__ void cvt_item(const float* W, const float* gain, int K, int Nsrc, int Ndst, bf16* WT, LAS float* scr, int item, int lane) {
    const int nblk = Ndst / 64, kb = item / nblk, nb = item % nblk, k0 = 64 * kb, n0 = 64 * nb;
    const int n4 = (lane & 15) * 4, kq = lane >> 4;
    const int src = map_src<TYPE>(n0 + n4);
    const float* wp = W + (size_t)(k0 + kq) * Nsrc + (src >= 0 ? src : 0);
#pragma unroll 8
    for (int it = 0; it < 16; ++it) { const int kk = kq + 4 * it;
        f32x4 v = (src >= 0) ? __builtin_nontemporal_load((const f32x4*)(wp + (size_t)(4 * it) * Nsrc)) : (f32x4){0.f, 0.f, 0.f, 0.f};
        if (HASG) v = v * gain[k0 + kk]; if (HALVE) v = v * 0.5f;
        scr[kk * 64 + ((n4 + 0) ^ kk)] = v.x; scr[kk * 64 + ((n4 + 1) ^ kk)] = v.y; scr[kk * 64 + ((n4 + 2) ^ kk)] = v.z; scr[kk * 64 + ((n4 + 3) ^ kk)] = v.w; }
    asm volatile("s_waitcnt lgkmcnt(0)" ::: "memory");
    const int c = lane & 7;
#pragma unroll
    for (int j = 0; j < 8; ++j) { const int n = (lane >> 3) + 8 * j; float t[8];
#pragma unroll
        for (int i = 0; i < 8; ++i) t[i] = scr[(8 * c + i) * 64 + (n ^ (8 * c + i))];
        v4u o; o.x = pk2(t[0], t[1]); o.y = pk2(t[2], t[3]); o.z = pk2(t[4], t[5]); o.w = pk2(t[6], t[7]);
        *(v4u*)(WT + (size_t)(n0 + n) * K + k0 + 8 * c) = o; }
    asm volatile("s_waitcnt lgkmcnt(0)" ::: "memory");
}
__device__ __forceinline__ void x_row(const float* xrow, bf16* hbrow, float* ssq, int lane) {
    const f32x4* xr = (const f32x4*)xrow + lane;
    f32x4 v[4]; float s = 0.f;
#pragma unroll
    for (int j = 0; j < 4; ++j) { v[j] = xr[64 * j]; s += (v[j].x * v[j].x + v[j].y * v[j].y) + (v[j].z * v[j].z + v[j].w * v[j].w); }
    unsigned long long* o8 = (unsigned long long*)hbrow + lane;
#pragma unroll
    for (int j = 0; j < 4; ++j) o8[64 * j] = (unsigned long long)pk2(v[j].x, v[j].y) | ((unsigned long long)pk2(v[j].z, v[j].w) << 32);
    s = wave_sum(s);
    if (lane < 16) ssq[lane] = (lane == 0) ? s : 0.f;
}
#define CVT_WEIGHTS(LL, WANT_PG, WANT_REST) do                 { \
                    LAS float* scr = (LAS float*)((LAS unsigned char*)lds + wave * 16384); \
                    constexpr int I_GU = 16 * 88, I_DN = 44 * 16, I_IN = 16 * 68, I_CO = 8 * 16, I_UQ = 6 * 24, I_UKV = 4 * 32, I_SQ = 16 * 16, I_PP = 4 * 16; \
                    constexpr int NITEMS = 2 * I_GU + 2 * I_DN + I_IN + I_CO + I_UQ + I_UKV + 3 * I_SQ + I_PP; \
                    const size_t L = (size_t)(LL); \
                    for (int it = gw; it < NITEMS; it += NGW) { \
                        int r = it; \
                        if (r < I_GU) { if (WANT_REST) cvt_item<1, true>(INP(4) + L * 1024 * 5632, INP(3) + L * 1024, 1024, 5632, 5632, (bf16*)(WB + WO_GU1), scr, r, lane); continue; } r -= I_GU; \
                        if (r < I_GU) { if (WANT_REST) cvt_item<1, true>(INP(17) + L * 1024 * 5632, INP(16) + L * 1024, 1024, 5632, 5632, (bf16*)(WB + WO_GU2), scr, r, lane); continue; } r -= I_GU; \
                        if (r < I_DN) { if (WANT_REST) cvt_item<0, false, true>(INP(5) + L * 2816 * 1024, nullptr, 2816, 1024, 1024, (bf16*)(WB + WO_DN1), scr, r, lane); continue; } r -= I_DN; \
                        if (r < I_DN) { if (WANT_REST) cvt_item<0, false, true>(INP(18) + L * 2816 * 1024, nullptr, 2816, 1024, 1024, (bf16*)(WB + WO_DN2), scr, r, lane); continue; } r -= I_DN; \
                        if (r < I_IN) { if (WANT_REST) cvt_item<2, true>(INP(7) + L * 1024 * 4288, INP(6) + L * 1024, 1024, 4288, 4352, (bf16*)(WB + WO_IN), scr, r, lane); continue; } r -= I_IN; \
                        if (r < I_CO) { if (WANT_REST) cvt_item<0, false>(INP(9) + L * 512 * 1024, nullptr, 512, 1024, 1024, (bf16*)(WB + WO_CO), scr, r, lane); continue; } r -= I_CO; \
                        if (r < I_UQ) { if (WANT_REST) cvt_item<3, true>(INP(12) + L * 384 * 1536, INP(10) + L * 384, 384, 1536, 1536, (bf16*)(WB + WO_UQ), scr, r, lane); continue; } r -= I_UQ; \
                        if (r < I_UKV) { if (WANT_REST) cvt_item<4, true>(INP(13) + L * 256 * 2048, INP(11) + L * 256, 256, 2048, 2048, (bf16*)(WB + WO_UKV), scr, r, lane); continue; } r -= I_UKV; \
                        if (r < I_SQ) { if (WANT_REST) cvt_item<0, false>(INP(14) + L * 1024 * 1024, nullptr, 1024, 1024, 1024, (bf16*)(WB + WO_MO), scr, r, lane); continue; } r -= I_SQ; \
                        if (r < I_SQ) { if (WANT_REST) cvt_item<0, false>(INP(15) + L * 1024 * 1024, nullptr, 1024, 1024, 1024, (bf16*)(WB + WO_WO), scr, r, lane); continue; } r -= I_SQ; \
                        if (r < I_SQ) { if (WANT_PG) cvt_item<0, true>(INP(20) + L * 1024 * 1024, INP(19) + L * 1024, 1024, 1024, 1024, (bf16*)(WB + WO_PG), scr, r, lane); continue; } r -= I_SQ; \
                        if (WANT_REST) cvt_item<0, false>(INP(21) + L * 256 * 1024, nullptr, 256, 1024, 1024, (bf16*)(WB + WO_PP), scr, r, lane); \
                    } \
                } while (0)
__global__ void __launch_bounds__(NWAVES * 64, 2) mega_fwd(Args a) {
    extern __shared__ __attribute__((aligned(16))) unsigned char lds[];
    cg::grid_group grid = cg::this_grid();
    const int G = gridDim.x, bx = blockIdx.x, NGW = G * NWAVES;
    const int vcu = (G % 8 == 0) ? (bx % 8) * (G / 8) + bx / 8 : bx;
#define INP(k) ({ int _k = (k); asm volatile("" : "+s"(_k)); a.in[_k]; })
    float* h = a.out;

    for (int u = threadIdx.x; u < (LDS_BYTES - RING_BYTES) / 4; u += NWAVES * 64) ((LAS unsigned*)((LAS unsigned char*)lds + RING_BYTES))[u] = 0u;
    __syncthreads();
    const XcdBarrier bar = xcd_barrier_post((unsigned*)(a.ws + WS_CTL), (volatile LAS unsigned*)((LAS unsigned char*)lds + MISC_OFF) + 8);
    for (int layer = 0; layer < DEPTH; ++layer) {
        for (int step = 0; step < 12; ++step) {
    unsigned char* ws = a.ws; asm volatile("" : "+s"(ws));
    int tid_ = threadIdx.x; asm volatile("" : "+v"(tid_)); const int tid = tid_, lane = tid & 63, wave = __builtin_amdgcn_readfirstlane(tid >> 6), gw = bx * NWAVES + wave;
    float* cosT = (float*)(ws + WS_COS); float* sinT = (float*)(ws + WS_SIN); float* SSQ = (float*)(ws + WS_SSQ);
    bf16* XN = (bf16*)(ws + WS_XN); bf16* CONV = (bf16*)(ws + WS_CONV); bf16* QB = (bf16*)(ws + WS_Q); bf16* PB = (bf16*)(ws + WS_PB); bf16* PP = (bf16*)(ws + WS_PP);
    bf16* LORA = (bf16*)(ws + WS_LORA); bf16* QN = (bf16*)(ws + WS_QN); bf16* KVN = (bf16*)(ws + WS_KVN); bf16* ATT = (bf16*)(ws + WS_ATTN);
    bf16* GATES = (bf16*)(ws + WS_GATES); bf16* YCB = (bf16*)(ws + WS_YCB); bf16* KROPE = (bf16*)(ws + WS_KROPE); bf16* KNOPE = (bf16*)(ws + WS_KNOPE);
    bf16* QNP = (bf16*)((unsigned char*)h + (size_t)MTOK * DM * 2); bf16* QRP = (bf16*)(ws + WS_XN);     float* LSSQ = (float*)(ws + WS_LSSQ); bf16* VB = (bf16*)(ws + WS_V); bf16* HID = (bf16*)(ws + WS_HID); bf16* HB = (bf16*)h;     bf16* HB2 = XN;
    unsigned char* WB = ws + WS_W;
            if (step == 0 && layer > 0) {
                continue;
            } else if (step == 0) {
                CVT_WEIGHTS(layer, true, true);
                if (layer == 0) {
                    const int* pos = (const int*)INP(2);
                    for (int idx = bx * 512 + tid; idx < MTOK * 32; idx += G * 512) {
                        const int m = idx >> 5, i = idx & 31;
                        const float ang = (float)pos[m] * INV_FREQ[i];
                        double rev = (double)ang * 0.15915494309189535; rev -= __builtin_rint(rev);
                        const float rr = (float)(rev * 6.283185307179586);
                        cosT[idx] = __cosf(rr); sinT[idx] = __sinf(rr);
                    }
                    const float* x = INP(0);
                    for (int m = gw; m < MTOK; m += NGW) x_row(x + (size_t)m * DM, HB2 + (size_t)m * DM, SSQ + (size_t)m * 16, lane);
                }
            } else if (step == 4) {
                continue;
            } else if (step == 6) {
                for (int i = 0; i < 1024; ++i) {
                    const int idx = i * G + vcu; if (idx >= 1024) break;
                    const int c = idx & 255, rnd = idx >> 8, bh = c >> 2, s = c & 3;
                    const int qb = (rnd == 0) ? 15 - s : (rnd == 1) ? 11 - s : (rnd == 2) ? 4 + s : s;
                    att::attn_unit(bh >> 3, bh & 7, qb, QNP, QRP, KNOPE, KROPE, VB, ATT, (char*)lds);
                }
            } else {
                if (step == 11 && layer + 1 < DEPTH) { CVT_WEIGHTS(layer + 1, false, true); __syncthreads(); }
                if (step == 1 && layer > 0) { CVT_WEIGHTS(layer, true, false); __syncthreads(); }
                if (step == 5) {
                const float* cw = INP(8) + layer * 3 * 512;
                const int c0 = lane * 8;
                f32x4 w0a = *(const f32x4*)(cw + c0), w0b = *(const f32x4*)(cw + c0 + 4), w1a = *(const f32x4*)(cw + 512 + c0), w1b = *(const f32x4*)(cw + 512 + c0 + 4),
                      w2a = *(const f32x4*)(cw + 1024 + c0), w2b = *(const f32x4*)(cw + 1024 + c0 + 4);
#pragma unroll 4
                for (int m = gw; m < MTOK; m += NGW) {
                    const int t = m & (SEQ - 1);
                    const bf16* cr = CONV + (size_t)m * 1536;
                    f32x4 ya, yb;
                    { f32x4 ca, cb, va, vb; pg8::unpack8(*(const v4u*)(cr + 512 + c0), ca, cb); pg8::unpack8(*(const v4u*)(cr + 1024 + c0), va, vb); ya = w2a * (ca * va); yb = w2b * (cb * vb); }
                    if (t >= 1) { f32x4 ca, cb, va, vb; pg8::unpack8(*(const v4u*)(cr - 1536 + 512 + c0), ca, cb); pg8::unpack8(*(const v4u*)(cr - 1536 + 1024 + c0), va, vb); ya += w1a * (ca * va); yb += w1b * (cb * vb); }
                    if (t >= 2) { f32x4 ca, cb, va, vb; pg8::unpack8(*(const v4u*)(cr - 3072 + 512 + c0), ca, cb); pg8::unpack8(*(const v4u*)(cr - 3072 + 1024 + c0), va, vb); ya += w0a * (ca * va); yb += w0b * (cb * vb); }
                    { f32x4 ba, bb; pg8::unpack8(*(const v4u*)(cr + c0), ba, bb); *(v4u*)(YCB + (size_t)m * 512 + c0) = pg8::pack8(ba * ya, bb * yb); }
                }
                for (int g8 = gw; g8 < MTOK / 8; g8 += NGW) {
                    const size_t m = (size_t)g8 * 8 + (lane >> 3); const int j4 = (lane & 7) * 4;
                    const bf16* lr = LORA + m * 768 + 640;
                    const v2u a1 = *(const v2u*)(lr + j4), a2 = *(const v2u*)(lr + 32 + j4);
                    const f32x4 c = *(const f32x4*)(cosT + m * 32 + j4), s = *(const f32x4*)(sinT + m * 32 + j4);
                    const f32x4 x1 = {pg8::bf_lo(a1.x), pg8::bf_hi(a1.x), pg8::bf_lo(a1.y), pg8::bf_hi(a1.y)}, x2 = {pg8::bf_lo(a2.x), pg8::bf_hi(a2.x), pg8::bf_lo(a2.y), pg8::bf_hi(a2.y)};
                    const f32x4 y1 = x1 * c - x2 * s, y2 = x2 * c + x1 * s;
                    v2u o1, o2; o1.x = pk2(y1.x, y1.y); o1.y = pk2(y1.z, y1.w); o2.x = pk2(y2.x, y2.y); o2.y = pk2(y2.z, y2.w);
                    *(v2u*)(KROPE + m * 64 + j4) = o1; *(v2u*)(KROPE + m * 64 + 32 + j4) = o2;
                }
                }
                if (step == 8) {
                    const float* p = INP(1) + (size_t)layer * MTOK * 256;
                    for (int idx = bx * 512 + tid; idx < MTOK * 256 / 8; idx += G * 512) {
                        const f32x4 x0 = *(const f32x4*)(p + (size_t)idx * 8), x1 = *(const f32x4*)(p + (size_t)idx * 8 + 4);
                        v4u o; o.x = pk2(x0.x, x0.y); o.y = pk2(x0.z, x0.w); o.z = pk2(x1.x, x1.y); o.w = pk2(x1.z, x1.w);
                        *(v4u*)(PB + (size_t)idx * 8) = o;
                    }
                }
                const int ng = (step == 5 || step == 7 || step == 9) ? 2 : 1;
                constexpr size_t SQA = (size_t)MTOK * 16; float* sq0 = SSQ + (size_t)(layer * 4) * SQA;
                for (int gi = 0; gi < ng; ++gi) {
                    pg8::Gemm g; g.M = MTOK; g.lda = 0; pg8::Epi E{}; int sq_off = 0, sq_n4 = 4, sq_stride = 16; float sq_inv = 1.f / DM; E.h = h; E.cosT = cosT; E.sinT = sinT; E.scale = 1.f; E.hb = HB; E.rl = (LAS float*)((LAS unsigned char*)lds + RING_BYTES + 1024);
                    if (step == 1) { g.A = HB2; g.Bt = (const bf16*)(WB + WO_GU1); g.N = 5632; g.K = 1024; E.mode = pg8::EPI_GU; E.o0 = HID; E.ssq_in = sq0; }
                    else if (step == 9 && gi == 0) { g.A = HB; g.Bt = (const bf16*)(WB + WO_GU2); g.N = 5632; g.K = 1024; E.mode = pg8::EPI_GU; E.o0 = HID; E.ssq_in = sq0 + 2 * SQA; }
                    else if (step == 2 || step == 10) { g.A = HID; g.Bt = (const bf16*)(WB + (step == 2 ? WO_DN1 : WO_DN2)); g.N = 1024; g.K = 2816; E.mode = pg8::EPI_RES; E.ssq_out = sq0 + (step == 2 ? 1 : 3) * SQA; E.hsrc = (step == 2) ? HB2 : HB; }
                    else if (step == 3) { g.A = HB; g.Bt = (const bf16*)(WB + WO_IN); g.N = 4352; g.K = 1024; E.mode = pg8::EPI_SPLIT; E.o0 = CONV; E.ld0 = 1536; E.t1 = 6; E.o1 = GATES; E.ld1 = 2048; E.t2 = 14; E.sig1 = 1; E.o2 = LORA; E.ld2 = 768; E.ssq_in = sq0 + SQA; E.lssq = LSSQ; }
                    else if (step == 5 && gi == 0) { g.A = LORA; g.lda = 768; g.Bt = (const bf16*)(WB + WO_UQ); g.N = 1536; g.K = 384; E.mode = pg8::EPI_UQ; E.o0 = QNP; E.o1 = QRP; E.ssq_in = LSSQ; sq_off = 0; sq_n4 = 3; sq_stride = 32; sq_inv = 1.f / 384.f; }
                    else if (step == 5) { g.A = LORA + 384; g.lda = 768; E.ssq_in = LSSQ; sq_off = 12; sq_n4 = 2; sq_stride = 32; sq_inv = 1.f / 256.f; g.Bt = (const bf16*)(WB + WO_UKV); g.N = 2048; g.K = 256; E.mode = pg8::EPI_SPLIT; E.o0 = KNOPE; E.ld0 = 1024; E.t1 = 4; E.o1 = VB; E.ld1 = 1024; E.t2 = 1000; E.o2 = VB; E.ld2 = 1024; }
                    else if (step == 7 && gi == 0) { g.A = ATT; g.Bt = (const bf16*)(WB + WO_MO); g.N = 1024; g.K = 1024; E.mode = pg8::EPI_MO; E.o0 = XN; E.g = GATES; }
                    else if (step == 7) { g.A = YCB; g.Bt = (const bf16*)(WB + WO_CO); g.N = 1024; g.K = 512; E.mode = pg8::EPI_CO; E.o0 = XN; E.g = GATES; }
                    else if (step == 8) { g.A = XN; g.Bt = (const bf16*)(WB + WO_WO); g.N = 1024; g.K = 1024; E.mode = pg8::EPI_RES; E.scale = 1.f; E.ssq_out = sq0 + 2 * SQA; E.hsrc = HB; }
                    else if (step == 9) { g.A = PB; g.Bt = (const bf16*)(WB + WO_PP); g.N = 1024; g.K = 256; E.mode = pg8::EPI_SPLIT; E.o0 = PP; E.ld0 = 1024; E.t1 = 1000; E.t2 = 1000; E.o1 = PP; E.o2 = PP; E.ld1 = 1024; E.ld2 = 1024; }
                    else { g.A = HB; g.Bt = (const bf16*)(WB + WO_PG); g.N = 1024; g.K = 1024; E.mode = pg8::EPI_PLE; E.g = PP; E.ssq_in = sq0 + 3 * SQA; E.ssq_out = sq0 + 4 * SQA; E.hb2 = HB2; }
                    pg8::StaticOrder S; S.init(g.M, g.N, G, bx);
                    if (g.lda == 0) g.lda = g.K;
                    if (E.ssq_in) {
                        pg8::Unit uu;
                        for (int i = 0; S.next(i, uu); ++i)
                            if (tid < 256) { const f32x4* sp = (const f32x4*)(E.ssq_in + (size_t)(uu.pm * 256 + tid) * sq_stride + sq_off); f32x4 s4 = sp[0];
                                for (int q4 = 1; q4 < sq_n4; ++q4) s4 += sp[q4];
                                E.rl[i * 256 + tid] = 1.0f / sqrtf(((s4[0] + s4[1]) + (s4[2] + s4[3])) * sq_inv + EPS); }
                        __syncthreads();
                    }
                    pg8::gemm_phase<pg8::Epi, pg8::StaticOrder, true, true>((LAS unsigned char*)lds, g, S, E);
                }
            }
            if (a.ws == nullptr) grid.sync();     xcd_barrier(bar);
        }
    }
    { const float* gain = INP(22); const int tid = threadIdx.x, lane = tid & 63, wave = __builtin_amdgcn_readfirstlane(tid >> 6), gw = bx * NWAVES + wave;
      const bf16* HB2 = (const bf16*)(a.ws + WS_XN);
      for (int m = gw; m < MTOK; m += NGW) {
          const v4u* xr = (const v4u*)(HB2 + (size_t)m * DM) + lane * 2; f32x4 v[4];
          pg8::unpack8(xr[0], v[0], v[1]); pg8::unpack8(xr[1], v[2], v[3]);
          float s = 0.f;
#pragma unroll
          for (int j = 0; j < 4; ++j) s += (v[j].x * v[j].x + v[j].y * v[j].y) + (v[j].z * v[j].z + v[j].w * v[j].w);
          const float r = 1.0f / sqrtf(wave_sum(s) * (1.f / DM) + EPS);
          const f32x4* gr = (const f32x4*)gain + lane * 4; f32x4* orow = (f32x4*)(h + (size_t)m * DM) + lane * 4;
#pragma unroll
          for (int j = 0; j < 4; ++j) orow[j] = v[j] * r * gr[j];
      } }
}

extern "C" void kernel_launch(void* const* d_in, const int* in_sizes, int n_in, void* d_out, int out_size, void* d_ws, size_t ws_size, hipStream_t stream) {
    static int grid = 0;
    if (grid == 0) {
        if (n_in != 23 || out_size != MTOK * DM || ws_size < WS_END) { fprintf(stderr, "kernel_launch: unexpected shapes: n_in %d out %d ws %zu (need %zu)\n", n_in, out_size, ws_size, (size_t)WS_END); grid = -1; return; }
        int dev = 0, cus = 0, per_cu = 0;
        if (hipGetDevice(&dev) != hipSuccess || hipDeviceGetAttribute(&cus, hipDeviceAttributeMultiprocessorCount, dev) != hipSuccess) { grid = -1; return; }
        if (hipFuncSetAttribute((const void*)mega_fwd, hipFuncAttributeMaxDynamicSharedMemorySize, LDS_BYTES) != hipSuccess) { fprintf(stderr, "kernel_launch: hipFuncSetAttribute failed\n"); grid = -1; return; }
        if (hipOccupancyMaxActiveBlocksPerMultiprocessor(&per_cu, (const void*)mega_fwd, NWAVES * 64, LDS_BYTES) != hipSuccess || per_cu < 1) { fprintf(stderr, "kernel_launch: occupancy query says %d\n", per_cu); per_cu = 1; }
        (void)hipGetLastError();
        grid = cus * per_cu;
    }
    if (grid < 0) return;
    if (hipMemsetAsync((char*)d_ws + WS_CTL, 0, CTL_ZERO_BYTES, stream) != hipSuccess) { fprintf(stderr, "kernel_launch: memset failed\n"); return; }
    Args a{};
    for (int i = 0; i < 23; ++i) a.in[i] = (const float*)d_in[i];
    a.out = (float*)d_out; a.ws = (unsigned char*)d_ws;
    void* args[] = {&a};
    hipError_t e = hipLaunchCooperativeKernel((const void*)mega_fwd, dim3(grid), dim3(NWAVES * 64), args, LDS_BYTES, stream);
    if (e != hipSuccess) fprintf(stderr, "cooperative launch failed: %s (grid %d)\n", hipGetErrorString(e), grid);
}
```

```cpp
#include <hip/hip_runtime.h>
#include <hip/hip_cooperative_groups.h>
#include <cstdio>
#include <cstdint>
namespace cg = cooperative_groups;

constexpr int MTOK = 32768, DM = 1024, DFF = 2816, SEQ = 4096, DEPTH = 4;
constexpr float EPS = 1e-6f;
__constant__ float INV_FREQ[32] = {
 0x1.0000000000000p+0f, 0x1.7ff2220000000p-1f, 0x1.1feb340000000p-1f, 0x1.afd1360000000p-2f, 0x1.43d1360000000p-2f, 0x1.e5a8480000000p-3f, 0x1.6c310e0000000p-3f, 0x1.111aee0000000p-3f,
 0x1.99999a0000000p-4f, 0x1.33281c0000000p-4f, 0x1.ccab860000000p-5f, 0x1.59742a0000000p-5f, 0x1.030dc40000000p-5f, 0x1.8486a00000000p-6f, 0x1.235a720000000p-6f, 0x1.b4f7e20000000p-7f,
 0x1.47ae140000000p-7f, 0x1.eb73600000000p-8f, 0x1.7089380000000p-8f, 0x1.145cee0000000p-8f, 0x1.9e7c6e0000000p-9f, 0x1.36d21a0000000p-9f, 0x1.d22a500000000p-10f, 0x1.5d931c0000000p-10f,
 0x1.0624de0000000p-10f, 0x1.8929180000000p-11f, 0x1.26d42c0000000p-11f, 0x1.ba2e4c0000000p-12f, 0x1.4b96be0000000p-12f, 0x1.f150280000000p-13f, 0x1.74eea60000000p-13f, 0x1.17a8e40000000p-13f};

namespace pg8 {
#define PG8_LAS __attribute__((address_space(3)))
typedef unsigned short bf16_t;
typedef short bf16x8 __attribute__((ext_vector_type(8)));
typedef float f32x4 __attribute__((ext_vector_type(4)));
typedef unsigned u32x4 __attribute__((ext_vector_type(4)));
constexpr int BM = 256, BK = 64, HALF = 128, HTB = HALF * BK * 2  , STAGE_BYTES = 8 * HTB, NXCD = 8, WGM = 8;

__host__ __device__ __forceinline__ int lds_byte(int r, int c) { const int st = (r >> 4) * 2 + (c >> 5), rr = r & 15, cc = c & 31, ob = rr * 64 + cc * 2; return st * 1024 + (ob ^ (((ob >> 9) & 1) << 5)); }
__host__ __device__ __forceinline__ void stage_rc(int b, int& R, int& C) { const int st = b / 1024, sb = b % 1024, swz = sb ^ (((sb >> 9) & 1) << 5); R = (st >> 1) * 16 + swz / 64; C = (st & 1) * 32 + (swz % 64) / 2; }
__host__ __device__ __forceinline__ int perm32(int rho) { const int n = rho >> 4, i = rho & 15; return 8 * (i >> 2) + 4 * n + (i & 3); }

struct Unit { int pm, pn; };
struct Gemm { const bf16_t* A; const bf16_t* Bt; int M, N, K, lda; };

struct StaticOrder {
    int nM, nN, nwg, G, c;
    __host__ __device__ void init(int M, int N, int G_, int c_) { nM = M / BM; nN = N / BM; nwg = nM * nN; G = G_; c = c_; }
    __host__ __device__ bool next(int i, Unit& u) const {
        const long L = (long)i * G + c; if (L >= nwg) return false;
        int wgid = (int)L; { const int q = nwg / NXCD, r = nwg % NXCD, xcd = wgid % NXCD, off = wgid / NXCD; wgid = (xcd < r ? xcd * (q + 1) : r * (q + 1) + (xcd - r) * q) + off; }
        const int nig = WGM * nN, gid = wgid / nig, fm = gid * WGM, gsz = (nM - fm) < WGM ? (nM - fm) : WGM;
        u.pm = fm + ((wgid % nig) % gsz); u.pn = (wgid % nig) / gsz; return true;
    }
    __device__ __forceinline__ void a_ready(const Unit&) const {}
    __device__ __forceinline__ void done(const Unit&) const {}
};

typedef unsigned u32x2 __attribute__((ext_vector_type(2)));
typedef _Float16 h16x8 __attribute__((ext_vector_type(8)));
__device__ __forceinline__ unsigned cvt_pk_bf16(float lo, float hi) { unsigned r; asm volatile("v_cvt_pk_bf16_f32 %0, %1, %2" : "=v"(r) : "v"(lo), "v"(hi)); return r; }
__device__ __forceinline__ float sigm(float x) { return __builtin_amdgcn_rcpf(1.f + __builtin_amdgcn_exp2f(-1.4426950408889634f * x)); }
__device__ __forceinline__ float bf_lo(unsigned w) { return __builtin_bit_cast(float, w << 16); }
__device__ __forceinline__ float bf_hi(unsigned w) { return __builtin_bit_cast(float, w & 0xffff0000u); }
__device__ __forceinline__ u32x4 pack8(const f32x4& a, const f32x4& b) { u32x4 w; w.x = cvt_pk_bf16(a[0], a[1]); w.y = cvt_pk_bf16(a[2], a[3]); w.z = cvt_pk_bf16(b[0], b[1]); w.w = cvt_pk_bf16(b[2], b[3]); return w; }
__device__ __forceinline__ void unpack8(const u32x4& w, f32x4& a, f32x4& b) { a[0] = bf_lo(w.x); a[1] = bf_hi(w.x); a[2] = bf_lo(w.y); a[3] = bf_hi(w.y); b[0] = bf_lo(w.z); b[1] = bf_hi(w.z); b[2] = bf_lo(w.w); b[3] = bf_hi(w.w); }

enum { EPI_GU = 0, EPI_RES = 1, EPI_SPLIT = 2, EPI_UQ = 3, EPI_MO = 4, EPI_CO = 5, EPI_PLE = 6 };
struct Epi {
    int mode; float scale;
    float* h;
    bf16_t* o0; bf16_t* o1; bf16_t* o2; int ld0, ld1, ld2, t1, t2, sig1;
    const bf16_t* g;
    const float* cosT; const float* sinT;
    const float* ssq_in; float* ssq_out; bf16_t* hb; bf16_t* hb2; const bf16_t* hsrc; float* lssq; PG8_LAS float* rl;
    mutable int ui;
    __device__ __forceinline__ void init_acc(f32x4 (&acc)[2][2][4][2], const Unit& u, int wr, int wc, int fr, int fq) const {
        if (mode == EPI_RES) {
            const bf16_t* base = hsrc + (size_t)(u.pm * BM + wr * 64 + fr) * DM + u.pn * BM + wc * 32 + 8 * fq;
            u32x4 t[2][4][2];
#pragma unroll
            for (int ai = 0; ai < 2; ++ai)
#pragma unroll
                for (int m = 0; m < 4; ++m)
#pragma unroll
                    for (int bj = 0; bj < 2; ++bj) t[ai][m][bj] = *(const u32x4*)(base + (size_t)(ai * HALF + m * 16) * DM + bj * HALF);
#pragma unroll
            for (int ai = 0; ai < 2; ++ai)
#pragma unroll
                for (int m = 0; m < 4; ++m)
#pragma unroll
                    for (int bj = 0; bj < 2; ++bj) unpack8(t[ai][m][bj], acc[ai][bj][m][0], acc[ai][bj][m][1]);
        } else {
#pragma unroll
            for (int ai = 0; ai < 2; ++ai)
#pragma unroll
                for (int bj = 0; bj < 2; ++bj)
#pragma unroll
                    for (int m = 0; m < 4; ++m) { acc[ai][bj][m][0] = (f32x4){0.f, 0.f, 0.f, 0.f}; acc[ai][bj][m][1] = (f32x4){0.f, 0.f, 0.f, 0.f}; }
        }
    }
    __device__ __forceinline__ void operator()(f32x4 (&acc)[2][2][4][2], const Unit& u, int wr, int wc, int fr, int fq) const {
        const int row0 = u.pm * BM + wr * 64 + fr;
        float rs[2][4];
        if (ssq_in) {
#pragma unroll
            for (int ai = 0; ai < 2; ++ai)
#pragma unroll
                for (int m = 0; m < 4; ++m) rs[ai][m] = rl[ui * BM + wr * 64 + ai * HALF + m * 16 + fr];
        } else {
#pragma unroll
            for (int ai = 0; ai < 2; ++ai)
#pragma unroll
                for (int m = 0; m < 4; ++m) rs[ai][m] = 1.f;
        }
        ++ui;
        if (mode == EPI_GU) {
            const int col = u.pn * 128 + wc * 32 + 8 * fq;
#pragma unroll
            for (int ai = 0; ai < 2; ++ai)
#pragma unroll
                for (int m = 0; m < 4; ++m) { f32x4 r0, r1;
#pragma unroll
                    for (int j = 0; j < 4; ++j) { const float g0 = acc[ai][0][m][0][j] * rs[ai][m], g1 = acc[ai][0][m][1][j] * rs[ai][m]; r0[j] = g0 * sigm(g0) * (acc[ai][1][m][0][j] * rs[ai][m]); r1[j] = g1 * sigm(g1) * (acc[ai][1][m][1][j] * rs[ai][m]); }
                    *(u32x4*)(o0 + (size_t)(row0 + ai * HALF + m * 16) * DFF + col) = pack8(r0, r1); }
        } else if (mode == EPI_RES) {
#pragma unroll
            for (int ai = 0; ai < 2; ++ai)
#pragma unroll
                for (int m = 0; m < 4; ++m) { const size_t row = (size_t)(row0 + ai * HALF + m * 16); const int col = u.pn * BM + wc * 32 + 8 * fq; float sq = 0.f;
#pragma unroll
                    for (int bj = 0; bj < 2; ++bj) { const f32x4 a = acc[ai][bj][m][0], b = acc[ai][bj][m][1];
                        *(u32x4*)(hb + row * DM + col + bj * HALF) = pack8(a, b);
                        sq += (a[0] * a[0] + a[1] * a[1]) + (a[2] * a[2] + a[3] * a[3]) + (b[0] * b[0] + b[1] * b[1]) + (b[2] * b[2] + b[3] * b[3]); }
                    sq += __shfl_xor(sq, 16); sq += __shfl_xor(sq, 32);
                    if (fq == 0) ssq_out[row * 16 + u.pn * 4 + wc] = sq;
                    }
        } else if (mode == EPI_SPLIT) {
            bf16_t* base; int ld, colt; bool sg = false;
            if (u.pn < t1) { base = o0; ld = ld0; colt = u.pn * BM; } else if (u.pn < t2) { base = o1; ld = ld1; colt = (u.pn - t1) * BM; sg = sig1 != 0; } else { base = o2; ld = ld2; colt = (u.pn - t2) * BM; }
#pragma unroll
            for (int ai = 0; ai < 2; ++ai)
#pragma unroll
                for (int m = 0; m < 4; ++m) { bf16_t* rowp = base + (size_t)(row0 + ai * HALF + m * 16) * ld + colt + wc * 32 + 8 * fq;
#pragma unroll
                    for (int bj = 0; bj < 2; ++bj) { f32x4 a = acc[ai][bj][m][0] * rs[ai][m], b = acc[ai][bj][m][1] * rs[ai][m];
                        if (sg) {
#pragma unroll
                            for (int j = 0; j < 4; ++j) { a[j] = sigm(a[j]); b[j] = sigm(b[j]); } }
                        *(u32x4*)(rowp + bj * HALF) = pack8(a, b);
                        if (lssq && u.pn >= t2) {
                            float sq = (a[0] * a[0] + a[1] * a[1]) + (a[2] * a[2] + a[3] * a[3]) + (b[0] * b[0] + b[1] * b[1]) + (b[2] * b[2] + b[3] * b[3]);
                            sq += __shfl_xor(sq, 16); sq += __shfl_xor(sq, 32);
                            if (fq == 0) lssq[(size_t)(row0 + ai * HALF + m * 16) * 32 + (u.pn - t2) * 8 + bj * 4 + wc] = sq; } } }
        } else if (mode == EPI_UQ) {
            if (u.pn < 4) {
#pragma unroll
                for (int ai = 0; ai < 2; ++ai)
#pragma unroll
                    for (int m = 0; m < 4; ++m) { bf16_t* rowp = o0 + (size_t)(row0 + ai * HALF + m * 16) * 1024 + u.pn * BM + wc * 32 + 8 * fq;
#pragma unroll
                        for (int bj = 0; bj < 2; ++bj) *(u32x4*)(rowp + bj * HALF) = pack8(acc[ai][bj][m][0] * rs[ai][m], acc[ai][bj][m][1] * rs[ai][m]); }
            } else {
                const int i0 = (wc & 1) * 16 + 4 * fq;
#pragma unroll
                for (int ai = 0; ai < 2; ++ai)
#pragma unroll
                    for (int m = 0; m < 4; ++m) { const int row = row0 + ai * HALF + m * 16;
                        const f32x4 cs = *(const f32x4*)(cosT + (size_t)row * 32 + i0), sn = *(const f32x4*)(sinT + (size_t)row * 32 + i0);
#pragma unroll
                        for (int bj = 0; bj < 2; ++bj) { const int head = (u.pn - 4) * 4 + 2 * bj + (wc >> 1);
                            const f32x4 x1 = acc[ai][bj][m][0] * rs[ai][m], x2 = acc[ai][bj][m][1] * rs[ai][m]; const f32x4 y1 = x1 * cs - x2 * sn, y2 = x2 * cs + x1 * sn;
                            bf16_t* p = o1 + (size_t)row * 512 + head * 64 + i0;
                            u32x2 w1, w2; w1.x = cvt_pk_bf16(y1[0], y1[1]); w1.y = cvt_pk_bf16(y1[2], y1[3]); w2.x = cvt_pk_bf16(y2[0], y2[1]); w2.y = cvt_pk_bf16(y2[2], y2[3]);
                            *(u32x2*)p = w1; *(u32x2*)(p + 32) = w2; } }
            }
        } else if (mode == EPI_MO || mode == EPI_CO) {
            const int goff = (mode == EPI_MO) ? 1024 : 0;
#pragma unroll
            for (int ai = 0; ai < 2; ++ai)
#pragma unroll
                for (int m = 0; m < 4; ++m) { const size_t row = (size_t)(row0 + ai * HALF + m * 16); const int col = u.pn * BM + wc * 32 + 8 * fq;
#pragma unroll
                    for (int bj = 0; bj < 2; ++bj) { f32x4 ga, gb; unpack8(*(const u32x4*)(g + row * 2048 + goff + col + bj * HALF), ga, gb);
                        f32x4 a = ga * acc[ai][bj][m][0], b = gb * acc[ai][bj][m][1];
                        bf16_t* p = o0 + row * DM + col + bj * HALF;
                        if (mode == EPI_CO) { f32x4 pa, pb; unpack8(*(const u32x4*)p, pa, pb); a += pa; b += pb; }
                        *(u32x4*)p = pack8(a, b); } }
        } else {
#pragma unroll
            for (int ai = 0; ai < 2; ++ai)
#pragma unroll
                for (int m = 0; m < 4; ++m) { const size_t row = (size_t)(row0 + ai * HALF + m * 16); const int col = u.pn * BM + wc * 32 + 8 * fq; float sq = 0.f;
#pragma unroll
                    for (int bj = 0; bj < 2; ++bj) { f32x4 pa, pb, a, b; unpack8(*(const u32x4*)(g + row * DM + col + bj * HALF), pa, pb); unpack8(*(const u32x4*)(hb + row * DM + col + bj * HALF), a, b);
#pragma unroll
                        for (int j = 0; j < 4; ++j) { a[j] += sigm(acc[ai][bj][m][0][j] * rs[ai][m]) * pa[j]; b[j] += sigm(acc[ai][bj][m][1][j] * rs[ai][m]) * pb[j]; }
                        *(u32x4*)(hb2 + row * DM + col + bj * HALF) = pack8(a, b);
                        sq += (a[0] * a[0] + a[1] * a[1]) + (a[2] * a[2] + a[3] * a[3]) + (b[0] * b[0] + b[1] * b[1]) + (b[2] * b[2] + b[3] * b[3]); }
                    sq += __shfl_xor(sq, 16); sq += __shfl_xor(sq, 32);
                    if (fq == 0) ssq_out[row * 16 + u.pn * 4 + wc] = sq;
                    }
        }
    }
};
template <class Epi, class Sched, bool ALIGN_EPI = false, bool SP2 = false>
__device__ __forceinline__ void gemm_phase(PG8_LAS unsigned char* lds, const Gemm g, const Sched& S, const Epi& E) {
    int tid_ = threadIdx.x; asm volatile("" : "+v"(tid_)); const int tid = tid_, wid = __builtin_amdgcn_readfirstlane(tid >> 6), lane = tid & 63, wr = wid >> 2, wc = wid & 3, fr = lane & 15, fq = lane >> 4;
    const int K = g.K, nt = K / BK;
    unsigned voffA[2], voffB[2];
#pragma unroll
    for (int i = 0; i < 2; ++i) { int R, C; stage_rc(tid * 16 + i * 8192, R, C); const int Rb = true ? ((R & ~31) + perm32(R & 31)) : R;
        voffA[i] = (unsigned)(R * g.lda + C) * 2u; voffB[i] = (unsigned)(Rb * K + C) * 2u; }
    const size_t kstep = (size_t)(BK * 2);
    const size_t hstepA = (size_t)HALF * g.lda * 2, hstep = (size_t)HALF * K * 2;
    const size_t tstepA = 2 * hstepA, tstep = 2 * hstep;
    const unsigned ldsw = (unsigned)wid * 1024u;
    const int aoff = lds_byte(wr * 64 + fr, fq * 8), boff = lds_byte(wc * 32 + fr, fq * 8);
#define PG8_SA(b, h) (((b) * 2 + (h)) * HTB)
#define PG8_SB(b, h) ((4 + (b) * 2 + (h)) * HTB)
#define PG8_STAGE(bufoff, gbase, voff) do { _Pragma("unroll") for (int _i = 0; _i < 2; ++_i) \
        __builtin_amdgcn_global_load_lds((const unsigned*)((const char*)(gbase) + (voff)[_i]), (PG8_LAS unsigned*)(lds + (bufoff) + ldsw + _i * 8192), 16, 0, 0); } while (0)
#define PG8_LDA(dst, b, h) do { _Pragma("unroll") for (int m = 0; m < 4; ++m) _Pragma("unroll") for (int k = 0; k < 2; ++k) dst[m][k] = *(const PG8_LAS bf16x8*)(lds + PG8_SA(b, h) + aoff + m * 2048 + k * 1024); } while (0)
#define PG8_LDB(dst, b, h) do { _Pragma("unroll") for (int n = 0; n < 2; ++n) _Pragma("unroll") for (int k = 0; k < 2; ++k) dst[n][k] = *(const PG8_LAS bf16x8*)(lds + PG8_SB(b, h) + boff + n * 2048 + k * 1024); } while (0)
#define PG8_MMA(ai, bj, At, Bt) do { __builtin_amdgcn_s_setprio(1); _Pragma("unroll") for (int m = 0; m < 4; ++m) _Pragma("unroll") for (int n = 0; n < 2; ++n) _Pragma("unroll") for (int k = 0; k < 2; ++k) \
        acc[ai][bj][m][n] = __builtin_amdgcn_mfma_f32_16x16x32_bf16(Bt[n][k], At[m][k], acc[ai][bj][m][n], 0, 0, 0); __builtin_amdgcn_s_setprio(0); } while (0)
#define PG8_WAIT_V(n) asm volatile("s_waitcnt vmcnt(" #n ")" ::: "memory")
#define PG8_WAIT_L(n) asm volatile("s_waitcnt lgkmcnt(" #n ")" ::: "memory")
#define PG8_BAR __builtin_amdgcn_s_barrier()
#define PG8_SCHED __builtin_amdgcn_sched_barrier(0)
    Unit cur, nxt; int ui = 0;
    if (!S.next(0, cur)) return;
    f32x4 acc[2][2][4][2];
    E.init_acc(acc, cur, wr, wc, fr, fq);
    bf16x8 At[4][2], B0[2][2], B1[2][2];
    const char* cA = (const char*)g.A + (size_t)cur.pm * tstepA; const char* cB = (const char*)g.Bt + (size_t)cur.pn * tstep;
    S.a_ready(cur);
    if constexpr (SP2) {
        PG8_STAGE(PG8_SB(0, 0), cB, voffB); PG8_STAGE(PG8_SB(0, 1), cB + hstep, voffB); PG8_STAGE(PG8_SA(0, 0), cA, voffA); PG8_STAGE(PG8_SA(0, 1), cA + hstepA, voffA);
        if (wr == 1) PG8_BAR;
        PG8_WAIT_V(2); PG8_BAR;
        PG8_STAGE(PG8_SB(1, 0), cB + kstep, voffB); PG8_STAGE(PG8_SA(1, 0), cA + kstep, voffA); PG8_STAGE(PG8_SB(1, 1), cB + hstep + kstep, voffB);
        PG8_WAIT_V(6); PG8_BAR;
    } else {
        PG8_STAGE(PG8_SB(0, 0), cB, voffB); PG8_STAGE(PG8_SA(0, 0), cA, voffA); PG8_STAGE(PG8_SB(0, 1), cB + hstep, voffB); PG8_STAGE(PG8_SA(0, 1), cA + hstepA, voffA);
        if (wr == 1) PG8_BAR;
        PG8_WAIT_V(4); PG8_BAR;
        PG8_STAGE(PG8_SB(1, 0), cB + kstep, voffB); PG8_STAGE(PG8_SA(1, 0), cA + kstep, voffA); PG8_STAGE(PG8_SB(1, 1), cB + hstep + kstep, voffB);
        PG8_WAIT_V(6); PG8_BAR;
    }
    for (;;) {
        const bool has_next = S.next(ui + 1, nxt);
        const char* nA = has_next ? (const char*)g.A + (size_t)nxt.pm * tstepA : cA; const char* nB = has_next ? (const char*)g.Bt + (size_t)nxt.pn * tstep : cB;
        for (int t = 0; t < nt; t += 2) {
            const bool last = (t == nt - 2);
            const char* a1 = cA + (size_t)(t + 1) * kstep;
            const char* a2 = last ? nA : cA + (size_t)(t + 2) * kstep; const char* b2 = last ? nB : cB + (size_t)(t + 2) * kstep;
            const char* a3 = a2 + kstep; const char* b3 = b2 + kstep;
            if (last && has_next) S.a_ready(nxt);
            if constexpr (SP2) {
            PG8_LDB(B0, 0, 0); PG8_LDB(B1, 0, 1); PG8_SCHED; PG8_LDA(At, 0, 0); PG8_STAGE(PG8_SA(1, 1), a1 + hstepA, voffA);
            PG8_WAIT_V(8); PG8_WAIT_L(0); PG8_BAR; PG8_MMA(0, 0, At, B0); PG8_MMA(0, 1, At, B1); PG8_BAR; PG8_SCHED;
            PG8_LDA(At, 0, 1); PG8_STAGE(PG8_SB(0, 0), b2, voffB); PG8_STAGE(PG8_SB(0, 1), b2 + hstep, voffB); PG8_STAGE(PG8_SA(0, 0), a2, voffA);
            PG8_WAIT_V(8); PG8_WAIT_L(0); PG8_BAR; PG8_MMA(1, 0, At, B0); PG8_MMA(1, 1, At, B1); PG8_BAR; PG8_SCHED;
            PG8_LDB(B0, 1, 0); PG8_LDB(B1, 1, 1); PG8_SCHED; PG8_LDA(At, 1, 0); PG8_STAGE(PG8_SA(0, 1), a2 + hstepA, voffA);
            PG8_WAIT_V(8); PG8_WAIT_L(0); PG8_BAR; PG8_MMA(0, 0, At, B0); PG8_MMA(0, 1, At, B1); PG8_BAR; PG8_SCHED;
            PG8_LDA(At, 1, 1); PG8_STAGE(PG8_SB(1, 0), b3, voffB); PG8_STAGE(PG8_SB(1, 1), b3 + hstep, voffB); PG8_STAGE(PG8_SA(1, 0), a3, voffA);
            PG8_WAIT_V(8); PG8_WAIT_L(0); PG8_BAR; PG8_MMA(1, 0, At, B0); PG8_MMA(1, 1, At, B1); PG8_BAR; PG8_SCHED;
            } else {
            PG8_LDB(B0, 0, 0); PG8_SCHED; PG8_LDA(At, 0, 0); PG8_STAGE(PG8_SA(1, 1), a1 + hstepA, voffA);
            PG8_WAIT_L(8); PG8_BAR; PG8_WAIT_L(0); PG8_MMA(0, 0, At, B0); PG8_BAR; PG8_SCHED;
            PG8_LDB(B1, 0, 1); PG8_STAGE(PG8_SB(0, 0), b2, voffB);
            PG8_BAR; PG8_WAIT_L(0); PG8_MMA(0, 1, At, B1); PG8_BAR;
            PG8_LDA(At, 0, 1); PG8_STAGE(PG8_SA(0, 0), a2, voffA);
            PG8_BAR; PG8_WAIT_L(0); PG8_MMA(1, 0, At, B0); PG8_BAR; PG8_SCHED;
            PG8_STAGE(PG8_SB(0, 1), b2 + hstep, voffB);
            PG8_WAIT_V(6); PG8_BAR; PG8_MMA(1, 1, At, B1); PG8_BAR;
            PG8_LDB(B0, 1, 0); PG8_SCHED; PG8_LDA(At, 1, 0); PG8_STAGE(PG8_SA(0, 1), a2 + hstepA, voffA);
            PG8_WAIT_L(8); PG8_BAR; PG8_WAIT_L(0); PG8_MMA(0, 0, At, B0); PG8_BAR; PG8_SCHED;
            PG8_LDB(B1, 1, 1); PG8_STAGE(PG8_SB(1, 0), b3, voffB);
            PG8_BAR; PG8_WAIT_L(0); PG8_MMA(0, 1, At, B1); PG8_BAR;
            PG8_LDA(At, 1, 1); PG8_STAGE(PG8_SA(1, 0), a3, voffA);
            PG8_BAR; PG8_WAIT_L(0); PG8_MMA(1, 0, At, B0); PG8_BAR; PG8_SCHED;
            PG8_STAGE(PG8_SB(1, 1), b3 + hstep, voffB);
            PG8_WAIT_V(6); PG8_BAR; PG8_MMA(1, 1, At, B1); PG8_BAR;
            }
        }
        if constexpr (ALIGN_EPI) { if (wr == 0) PG8_BAR; }
        if constexpr (!false) { E(acc, cur, wr, wc, fr, fq); S.done(cur); }
        if (!has_next) break;
        E.init_acc(acc, nxt, wr, wc, fr, fq);
        cur = nxt; cA = nA; cB = nB; ++ui;
        if constexpr (ALIGN_EPI) { if (wr == 1) PG8_BAR; }
    }
    PG8_WAIT_V(0);
    if constexpr (!ALIGN_EPI) { if (wr == 0) PG8_BAR; }
    PG8_BAR;
    if constexpr (false) { E.fused(acc, cur, wr, wc, fr, fq, lds, wid, lane); S.done(cur); }
#undef PG8_SA
#undef PG8_SB
#undef PG8_STAGE
#undef PG8_LDA
#undef PG8_LDB
#undef PG8_MMA
#undef PG8_WAIT_V
#undef PG8_WAIT_L
#undef PG8_BAR
#undef PG8_SCHED
}
}
namespace att {
using bf16x8 = __attribute__((ext_vector_type(8))) short;
using s16x4  = __attribute__((ext_vector_type(4))) short;
using f32x16 = __attribute__((ext_vector_type(16))) float;
using u32x4  = __attribute__((ext_vector_type(4))) unsigned;
typedef unsigned short bf16_t;
constexpr int NW = 8, QBLK = 32, KVBLK = 64;
constexpr float SCALE = 0.07216878364870322f;
constexpr float THR = 8.f;
constexpr int SHM_V = 16384, SHM_KN = 16384, SHM_KR = 8192;
constexpr int OFF_V = 0, OFF_KN = 2 * SHM_V, OFF_KR = OFF_KN + 2 * SHM_KN, OFF_WS = OFF_KR + 2 * SHM_KR, LDS_BYTES = OFF_WS + NW * 64 * 4;
#define KSWZ(row, colB) ((row) * 256 + ((colB) ^ (((row) & 7) << 4)))
#define KRSWZ(row, colB) ((row) * 128 + ((colB) ^ ((((row) >> 1) & 7) << 4)))
#define SBAR() __builtin_amdgcn_sched_barrier(0)
__device__ __forceinline__ int crow(int r, int hi) { return (r & 3) + 8 * (r >> 2) + 4 * hi; }
__device__ __forceinline__ unsigned cvtpk(float lo, float hi) { unsigned r; asm volatile("v_cvt_pk_bf16_f32 %0, %1, %2" : "=v"(r) : "v"(lo), "v"(hi)); return r; }

__device__ __forceinline__ void partialSM(f32x16& p0, f32x16& p1, float& m_reg, float& mn, float& alpha) {
  constexpr float C = SCALE * 1.4426950408889634f;
  float pmax = p0[0];
#pragma unroll
  for (int r = 1; r < 16; ++r) pmax = fmaxf(pmax, p0[r]);
#pragma unroll
  for (int r = 0; r < 16; ++r) pmax = fmaxf(pmax, p1[r]);
  { auto rr = __builtin_amdgcn_permlane32_swap(__float_as_uint(pmax), __float_as_uint(pmax), false, false);
    pmax = fmaxf(__uint_as_float(rr[0]), __uint_as_float(rr[1])); }
  if (__builtin_expect(__all(pmax - m_reg <= THR / SCALE), 1)) { mn = m_reg; alpha = 1.f; }
  else { mn = fmaxf(m_reg, pmax); alpha = __builtin_amdgcn_exp2f((m_reg - mn) * C); m_reg = mn; }
  float mnC = -mn * C;
#pragma unroll
  for (int r = 0; r < 16; ++r) p0[r] = fmaf(p0[r], C, mnC);
#pragma unroll
  for (int r = 0; r < 16; ++r) p1[r] = fmaf(p1[r], C, mnC);
#pragma unroll
  for (int r = 0; r < 16; ++r) p0[r] = __builtin_amdgcn_exp2f(p0[r]);
}
__device__ __forceinline__ void finishSM(f32x16& p0, f32x16& p1, float alpha, float& l_reg, bf16x8& pa0, bf16x8& pa1, bf16x8& pa2, bf16x8& pa3) {
#pragma unroll
  for (int r = 0; r < 16; ++r) p1[r] = __builtin_amdgcn_exp2f(p1[r]);
  float ps = 0;
#pragma unroll
  for (int r = 0; r < 16; ++r) ps += p0[r];
#pragma unroll
  for (int r = 0; r < 16; ++r) ps += p1[r];
  { auto rr = __builtin_amdgcn_permlane32_swap(__float_as_uint(ps), __float_as_uint(ps), false, false);
    ps = __uint_as_float(rr[0]) + __uint_as_float(rr[1]); }
  l_reg = l_reg * alpha + ps;
#define PK4(P, BASE, OUT) do { unsigned a0 = cvtpk(P[BASE + 0], P[BASE + 1]), a1 = cvtpk(P[BASE + 2], P[BASE + 3]);   \
    unsigned b0 = cvtpk(P[BASE + 4], P[BASE + 5]), b1 = cvtpk(P[BASE + 6], P[BASE + 7]);                              \
    auto r0 = __builtin_amdgcn_permlane32_swap(a0, b0, false, false); auto r1 = __builtin_amdgcn_permlane32_swap(a1, b1, false, false); \
    u32x4 w = {r0[0], r1[0], r0[1], r1[1]}; OUT = *reinterpret_cast<bf16x8*>(&w); } while (0)
  PK4(p0, 0, pa0); PK4(p0, 8, pa1); PK4(p1, 0, pa2); PK4(p1, 8, pa3);
#undef PK4
}
__device__ __forceinline__ void qkt(f32x16& p0, f32x16& p1, const char* Kn, const char* Kr, const bf16x8* qr, int r32, int hi, bool live) {
  if (live) {
    p0 = f32x16{}; p1 = f32x16{};
#pragma unroll
    for (int d0 = 0; d0 < 8; ++d0) { const int cb = (d0 * 16 + hi * 8) * 2;
      bf16x8 b0 = *reinterpret_cast<const bf16x8*>(Kn + KSWZ(r32, cb));
      bf16x8 b1 = *reinterpret_cast<const bf16x8*>(Kn + KSWZ(32 + r32, cb));
      p0 = __builtin_amdgcn_mfma_f32_32x32x16_bf16(b0, qr[d0], p0, 0, 0, 0);
      p1 = __builtin_amdgcn_mfma_f32_32x32x16_bf16(b1, qr[d0], p1, 0, 0, 0); }
#pragma unroll
    for (int d0 = 0; d0 < 4; ++d0) { const int cb = (d0 * 16 + hi * 8) * 2;
      bf16x8 b0 = *reinterpret_cast<const bf16x8*>(Kr + KRSWZ(r32, cb));
      bf16x8 b1 = *reinterpret_cast<const bf16x8*>(Kr + KRSWZ(32 + r32, cb));
      p0 = __builtin_amdgcn_mfma_f32_32x32x16_bf16(b0, qr[8 + d0], p0, 0, 0, 0);
      p1 = __builtin_amdgcn_mfma_f32_32x32x16_bf16(b1, qr[8 + d0], p1, 0, 0, 0); }
  } else {
#pragma unroll
    for (int r = 0; r < 16; ++r) { p0[r] = -1e30f; p1[r] = -1e30f; }
  }
}
__device__ __forceinline__ int v_st(int k, int c) { const int kk = (k & ~0xC) | ((k & 4) << 1) | ((k & 8) >> 1); return ((kk >> 3) * 4 + (c >> 5)) * 512 + ((kk & 7) * 32 + (c & 31)) * 2; }
__device__ __forceinline__ int v_rd_base(int lane) { return ((lane & 3) << 3) | (((lane >> 2) & 3) << 6) | (((lane >> 4) & 1) << 5) | (((lane >> 5) & 1) << 8); }
constexpr int v_rd_off(int d0, int ks, int half) { return d0 * 512 + ks * 4096 + half * 2048; }
template <int OFF> __device__ __forceinline__ s16x4 tr_read(int vb) {
  s16x4 r; asm volatile("ds_read_b64_tr_b16 %0, %1 offset:%2" : "=&v"(r) : "v"(vb), "i"(OFF) : "memory"); return r;
}
template <int D0> __device__ __forceinline__ void pv_one(f32x16& od, int vb, bf16x8 pa0, bf16x8 pa1, bf16x8 pa2, bf16x8 pa3) {
  const s16x4 l0 = tr_read<v_rd_off(D0, 0, 0)>(vb), h0 = tr_read<v_rd_off(D0, 0, 1)>(vb), l1 = tr_read<v_rd_off(D0, 1, 0)>(vb), h1 = tr_read<v_rd_off(D0, 1, 1)>(vb);
  const s16x4 l2 = tr_read<v_rd_off(D0, 2, 0)>(vb), h2 = tr_read<v_rd_off(D0, 2, 1)>(vb), l3 = tr_read<v_rd_off(D0, 3, 0)>(vb), h3 = tr_read<v_rd_off(D0, 3, 1)>(vb);
  asm volatile("s_waitcnt lgkmcnt(0)" ::: "memory"); SBAR();
#define PK(L, H) (bf16x8){L[0], L[1], L[2], L[3], H[0], H[1], H[2], H[3]}
  od = __builtin_amdgcn_mfma_f32_32x32x16_bf16(pa0, PK(l0, h0), od, 0, 0, 0);
  od = __builtin_amdgcn_mfma_f32_32x32x16_bf16(pa1, PK(l1, h1), od, 0, 0, 0);
  od = __builtin_amdgcn_mfma_f32_32x32x16_bf16(pa2, PK(l2, h2), od, 0, 0, 0);
  od = __builtin_amdgcn_mfma_f32_32x32x16_bf16(pa3, PK(l3, h3), od, 0, 0, 0);
#undef PK
}
__device__ __forceinline__ void pv_d0(f32x16* o, int vb, bf16x8 pa0, bf16x8 pa1, bf16x8 pa2, bf16x8 pa3) {
  pv_one<0>(o[0], vb, pa0, pa1, pa2, pa3); pv_one<1>(o[1], vb, pa0, pa1, pa2, pa3); pv_one<2>(o[2], vb, pa0, pa1, pa2, pa3); pv_one<3>(o[3], vb, pa0, pa1, pa2, pa3);
}

__device__ __forceinline__ void attn_unit(int b, int h, int qb, const bf16_t* __restrict__ Q, const bf16_t* __restrict__ QR, const bf16_t* __restrict__ KN, const bf16_t* __restrict__ KR, const bf16_t* __restrict__ V, bf16_t* __restrict__ O, char* lds) {
  int tid_ = threadIdx.x; asm volatile("" : "+v"(tid_)); const int tid = tid_, wid = __builtin_amdgcn_readfirstlane(tid >> 6), lane = tid & 63, r32 = lane & 31, hi = lane >> 5;
  char* V_lds = lds + OFF_V; char* Kn_lds = lds + OFF_KN; char* Kr_lds = lds + OFF_KR;
  float* ws = (float*)(lds + OFF_WS) + wid * 64; float* li_l = ws; float* al_l = ws + 32;
  const long rowbase = (long)b * SEQ; const int q0 = qb * 256;
  const int NT = (q0 + 256) / KVBLK;
  const int NTw = q0 / KVBLK + (wid >> 1) + 1;
  float m_reg = -1e30f, l_reg = 0; f32x16 o[4] = {}; bf16x8 qr[12];
  { const bf16_t* Qw = Q + (rowbase + q0 + wid * QBLK + r32) * 1024 + h * 128 + hi * 8;
    const bf16_t* Qr = QR + (rowbase + q0 + wid * QBLK + r32) * 512 + h * 64 + hi * 8;
#pragma unroll
    for (int d0 = 0; d0 < 8; ++d0) qr[d0] = *reinterpret_cast<const bf16x8*>(Qw + d0 * 16);
#pragma unroll
    for (int d0 = 0; d0 < 4; ++d0) qr[8 + d0] = *reinterpret_cast<const bf16x8*>(Qr + d0 * 16); }
  const bf16_t* Kh = KN + rowbase * 1024 + h * 128; const bf16_t* Vh = V + rowbase * 1024 + h * 128; const bf16_t* Krh = KR + rowbase * 64;
  const int sr = tid >> 4, sc = (tid & 15) * 8, vst0 = v_st(sr, sc), vst1 = v_st(32 + sr, sc);
  const int krr = tid >> 3, krc = (tid & 7) * 8;
  const int vb0 = (int)(uintptr_t)V_lds + v_rd_base(lane);
  bf16x8 vs0, vs1, ks0, ks1, kr0;
#define SLOAD_A(k0) do { vs0 = *reinterpret_cast<const bf16x8*>(&Vh[(long)((k0) + sr) * 1024 + sc]); vs1 = *reinterpret_cast<const bf16x8*>(&Vh[(long)((k0) + 32 + sr) * 1024 + sc]); } while (0)
#define SLOAD_R(k0) do { ks0 = *reinterpret_cast<const bf16x8*>(&Kh[(long)((k0) + sr) * 1024 + sc]); ks1 = *reinterpret_cast<const bf16x8*>(&Kh[(long)((k0) + 32 + sr) * 1024 + sc]); \
    kr0 = *reinterpret_cast<const bf16x8*>(&Krh[(long)((k0) + krr) * 64 + krc]); } while (0)
#define SLOAD(k0) do { SLOAD_A(k0); SLOAD_R(k0); } while (0)
#define SWRITE(bb) do { *(bf16x8*)(V_lds + (bb) * SHM_V + vst0) = vs0; *(bf16x8*)(V_lds + (bb) * SHM_V + vst1) = vs1; \
    *(bf16x8*)(Kn_lds + (bb) * SHM_KN + KSWZ(sr, sc * 2)) = ks0; *(bf16x8*)(Kn_lds + (bb) * SHM_KN + KSWZ(32 + sr, sc * 2)) = ks1; \
    *(bf16x8*)(Kr_lds + (bb) * SHM_KR + KRSWZ(krr, krc * 2)) = kr0; } while (0)
#define SWAIT() asm volatile("s_waitcnt vmcnt(0)" ::: "memory")
#define RESC(a) do { if (__any((a) < 1.f)) { if (hi == 0) al_l[r32] = (a); asm volatile("s_waitcnt lgkmcnt(0)" ::: "memory"); \
    _Pragma("unroll") for (int d = 0; d < 4; ++d) _Pragma("unroll") for (int r = 0; r < 16; ++r) o[d][r] *= al_l[crow(r, hi)]; } } while (0)
  f32x16 pA0, pA1, pB0, pB1; float mnA, mnB, alA, alB; bf16x8 pa0, pa1, pa2, pa3;
  SLOAD(0); SWAIT(); SWRITE(0); SLOAD(KVBLK); __syncthreads();
  qkt(pA0, pA1, Kn_lds, Kr_lds, qr, r32, hi, true); partialSM(pA0, pA1, m_reg, mnA, alA);
  SWAIT(); SWRITE(1); __syncthreads();
  for (int j = 1; j + 1 < NT; j += 2) {
    SBAR(); SLOAD_A((j + 1) * KVBLK); SBAR();
    qkt(pB0, pB1, Kn_lds + SHM_KN, Kr_lds + SHM_KR, qr, r32, hi, j < NTw);
    finishSM(pA0, pA1, alA, l_reg, pa0, pa1, pa2, pa3); SBAR();
    SLOAD_R((j + 1) * KVBLK); SBAR();
    pv_d0(o, vb0, pa0, pa1, pa2, pa3); partialSM(pB0, pB1, m_reg, mnB, alB);
    __syncthreads(); SWAIT(); SWRITE(0);
    RESC(alB); __syncthreads();
    SBAR(); SLOAD_A((j + 2) * KVBLK); SBAR();
    qkt(pA0, pA1, Kn_lds, Kr_lds, qr, r32, hi, j + 1 < NTw);
    finishSM(pB0, pB1, alB, l_reg, pa0, pa1, pa2, pa3); SBAR();
    SLOAD_R((j + 2) * KVBLK); SBAR();
    pv_d0(o, vb0 + SHM_V, pa0, pa1, pa2, pa3); partialSM(pA0, pA1, m_reg, mnA, alA);
    __syncthreads(); SWAIT(); SWRITE(1);
    RESC(alA); __syncthreads();
  }
  SBAR(); qkt(pB0, pB1, Kn_lds + SHM_KN, Kr_lds + SHM_KR, qr, r32, hi, NT - 1 < NTw);
  finishSM(pA0, pA1, alA, l_reg, pa0, pa1, pa2, pa3); SBAR();
  pv_d0(o, vb0, pa0, pa1, pa2, pa3); partialSM(pB0, pB1, m_reg, mnB, alB);
  __syncthreads(); RESC(alB);
  finishSM(pB0, pB1, alB, l_reg, pa0, pa1, pa2, pa3); SBAR();
  pv_d0(o, vb0 + SHM_V, pa0, pa1, pa2, pa3);
  if (hi == 0) li_l[r32] = l_reg; asm volatile("s_waitcnt lgkmcnt(0)" ::: "memory");
  float rli[16];
#pragma unroll
  for (int r = 0; r < 16; ++r) rli[r] = __builtin_amdgcn_rcpf(li_l[crow(r, hi)]);
  char* stg = lds + (wid < 2 ? wid * 8192 : 32768 + (wid - 2) * 8192);
#pragma unroll
  for (int r = 0; r < 16; ++r) { const int orow = crow(r, hi);
#pragma unroll
    for (int d0 = 0; d0 < 4; ++d0) { const float v = o[d0][r] * rli[r]; *(bf16_t*)(stg + orow * 256 + (d0 * 32 + r32) * 2) = (bf16_t)(cvtpk(v, v) & 0xffffu); } }
  asm volatile("s_waitcnt lgkmcnt(0)" ::: "memory");
  bf16_t* Ow = O + (rowbase + q0 + wid * QBLK) * 1024 + h * 128;
#pragma unroll
  for (int i = 0; i < 8; ++i) { const int chunk = i * 64 + lane, row = chunk >> 4, ch = chunk & 15;
    const u32x4 v = *(const u32x4*)(stg + row * 256 + ch * 16); *(u32x4*)(Ow + (long)row * 1024 + ch * 8) = v; }
  asm volatile("s_waitcnt lgkmcnt(0)" ::: "memory");
  __syncthreads();
#undef SLOAD
#undef SLOAD_A
#undef SLOAD_R
#undef SWRITE
#undef SWAIT
#undef RESC
}
#undef SBAR
}
typedef unsigned short bf16;
typedef unsigned v4u __attribute__((ext_vector_type(4)));
typedef unsigned v2u __attribute__((ext_vector_type(2)));
typedef float f32x4 __attribute__((ext_vector_type(4)));
#define LAS __attribute__((address_space(3)))
constexpr size_t MiB = 1u << 20;
#define XB_TMO      128
#define XB_XCNT(j)  (256  + 64 * (j))
#define XB_XSUB(j)  (1280 + 64 * (j))
#define XB_XGEN(j)  (2304 + 64 * (j))
#define XB_TOP      3328
#define XB_TOPGEN   3392
#define XCD_BAR_WORDS 3456
#define XB_SPIN_CAP (1u << 18)

__device__ __forceinline__ unsigned xb_ld(unsigned* p)              { return __hip_atomic_load(p, __ATOMIC_RELAXED, __HIP_MEMORY_SCOPE_AGENT); }
__device__ __forceinline__ unsigned xb_add(unsigned* p, unsigned v) { return __hip_atomic_fetch_add(p, v, __ATOMIC_RELAXED, __HIP_MEMORY_SCOPE_AGENT); }
__device__ __forceinline__ unsigned xb_xcc_id() { return (unsigned)__builtin_amdgcn_s_getreg((3 << 11) | 20) & 0xFu; }
#define XB_SPIN(cond, bar) do { unsigned _sp = 0; while (cond) { __builtin_amdgcn_s_sleep(1); \
    if ((++_sp & 255u) == 0u) { if (xb_ld(&(bar)[XB_TMO])) break; if (_sp > XB_SPIN_CAP) { atomicAdd(&(bar)[XB_TMO], 1u); break; } } } } while (0)

struct XcdBarrier {
    unsigned* bar; unsigned x;
    volatile LAS unsigned* st;
};

__device__ __forceinline__ XcdBarrier xcd_barrier_post(unsigned* bar, volatile LAS unsigned* st) {
    XcdBarrier b; b.bar = bar; b.x = xb_xcc_id(); b.st = st;
    if (threadIdx.x == 0) (void)xb_add(&bar[XB_XCNT(b.x)], 1u);
    return b;
}
__device__ __forceinline__ void xcd_barrier_complete(unsigned* bar, unsigned x, unsigned& nloc, unsigned& nx) {
    const unsigned G = gridDim.x * gridDim.y * gridDim.z;
    unsigned sum, cnt, mine, sp = 0u;
    for (;;) {
        sum = 0u; cnt = 0u; mine = 0u;
#pragma unroll
        for (unsigned j = 0; j < 16; ++j) { const unsigned c = xb_ld(&bar[XB_XCNT(j)]); sum += c; cnt += (c > 0u) ? 1u : 0u; mine = (j == x) ? c : mine; }
        if (sum == G) break;
        __builtin_amdgcn_s_sleep(1);
        if ((++sp & 255u) == 0u) { if (xb_ld(&bar[XB_TMO])) break; if (sp > XB_SPIN_CAP) { atomicAdd(&bar[XB_TMO], 1u); break; } }
    }
    nloc = mine > 0u ? mine : 1u; nx = cnt > 0u ? cnt : 1u;
}

__device__ __forceinline__ void xcd_barrier(const XcdBarrier& b) {
    asm volatile("s_waitcnt vmcnt(0)" ::: "memory");
    __syncthreads();
    if (threadIdx.x == 0) {
        unsigned* bar = b.bar;
        __builtin_amdgcn_s_waitcnt(0);
        unsigned nloc = b.st[0], nx = b.st[1];
        if (nloc == 0u) { xcd_barrier_complete(bar, b.x, nloc, nx); b.st[0] = nloc; b.st[1] = nx; }
        const unsigned old = xb_add(&bar[XB_XSUB(b.x)], 1u);
        const unsigned gen = old / nloc;
        if (old + 1u == (gen + 1u) * nloc) {
            __builtin_amdgcn_fence(__ATOMIC_RELEASE, "agent");
            asm volatile("s_waitcnt vmcnt(0)" ::: "memory");
            const unsigned og = xb_add(&bar[XB_TOP], 1u);
            const unsigned tg = og / nx;
            if (og + 1u == (tg + 1u) * nx) xb_add(&bar[XB_TOPGEN], 1u);
            else XB_SPIN(xb_ld(&bar[XB_TOPGEN]) == tg, bar);
            __builtin_amdgcn_fence(__ATOMIC_ACQUIRE, "agent");
            xb_add(&bar[XB_XGEN(b.x)], 1u);
            asm volatile("s_waitcnt vmcnt(0)" ::: "memory");
        } else {
            XB_SPIN(xb_ld(&bar[XB_XGEN(b.x)]) == gen, bar);
            __builtin_amdgcn_fence(__ATOMIC_ACQUIRE, "agent");
            asm volatile("s_waitcnt vmcnt(0)" ::: "memory");
        }
    }
    __syncthreads();
}

constexpr size_t WS_CTL = 0, CTL_ZERO_BYTES = 16384;
constexpr size_t WS_COS = 1 * MiB, WS_SIN = 5 * MiB, WS_W = 10 * MiB;
constexpr size_t WS_SSQ = 604 * MiB;
constexpr size_t WS_XN = 64 * MiB;
constexpr size_t WS_CONV = 128 * MiB;
constexpr size_t WS_Q = WS_CONV, WS_PB = WS_CONV, WS_PP = WS_CONV + 16 * MiB;
constexpr size_t WS_LORA = 224 * MiB;
constexpr size_t WS_QN = 272 * MiB;
constexpr size_t WS_KVN = 296 * MiB;
constexpr size_t WS_ATTN = 224 * MiB;
constexpr size_t WS_GATES = 312 * MiB;
constexpr size_t WS_YCB = 440 * MiB;
constexpr size_t WS_KROPE = 472 * MiB;
constexpr size_t WS_KNOPE = 476 * MiB;
constexpr size_t WS_V = 540 * MiB;
constexpr size_t WS_HB = WS_V;
constexpr size_t WS_HID = 312 * MiB;
constexpr size_t WS_LSSQ = 638 * MiB;
constexpr size_t WS_END = 642 * MiB;
constexpr size_t WO_GU1 = 0, WO_DN1 = WO_GU1 + (size_t)5632 * 1024 * 2, WO_IN = WO_DN1 + (size_t)1024 * 2816 * 2, WO_CO = WO_IN + (size_t)4352 * 1024 * 2,
    WO_UQ = WO_CO + (size_t)1024 * 512 * 2, WO_UKV = WO_UQ + (size_t)1536 * 384 * 2, WO_MO = WO_UKV + (size_t)2048 * 256 * 2, WO_WO = WO_MO + (size_t)1024 * 1024 * 2,
    WO_GU2 = WO_WO + (size_t)1024 * 1024 * 2, WO_DN2 = WO_GU2 + (size_t)5632 * 1024 * 2, WO_PG = WO_DN2 + (size_t)1024 * 2816 * 2, WO_PP = WO_PG + (size_t)1024 * 1024 * 2,
    WO_END = WO_PP + (size_t)1024 * 256 * 2;
static_assert(WS_W + WO_END <= WS_XN && WS_SSQ + 17 * (size_t)MTOK * 64 <= WS_END, "weights / ssq fit");

constexpr int NWAVES = 8, LDS_BYTES = 147456, RING_BYTES = 131072, MISC_OFF = RING_BYTES + 320;

struct Args { const float* in[23]; float* out; unsigned char* ws; };

__device__ __forceinline__ float wave_sum(float v) {
#pragma unroll
    for (int o = 1; o < 64; o <<= 1) v += __shfl_xor(v, o);
    return v;
}
__device__ __forceinline__ unsigned pk2(float lo, float hi) { return pg8::cvt_pk_bf16(lo, hi); }

template <int TYPE> __device__ __forceinline__ int map_src(int n) {
    if (TYPE == 0) return n;
    if (TYPE == 1) { const int pn = n >> 8, w = n & 255; return (w < 128) ? pn * 128 + w : 2816 + pn * 128 + (w - 128); }
    if (TYPE == 2) { if (n < 1536) return n; if (n < 3584) return n - 1536 + 2240; if (n < 4288) return n - 3584 + 1536; return -1; }
    if (TYPE == 3) { if (n < 1024) return (n >> 7) * 192 + (n & 127);
        const int m = n - 1024, head = m >> 6, w = m & 63, grp = w >> 5, within = w & 31, fqq = within >> 3, nn = (within >> 2) & 1, j = within & 3, i = grp * 16 + 4 * fqq + j;
        return head * 192 + 128 + (nn ? 32 : 0) + i; }
      { if (n < 1024) return (n >> 7) * 256 + (n & 127); const int m = n - 1024; return (m >> 7) * 256 + 128 + (m & 127); }
}
template <int TYPE, bool HASG, bool HALVE = false> __device__ __forceinline__ void cvt_item(const float* W, const float* gain, int K, int Nsrc, int Ndst, bf16* WT, LAS float* scr, int item, int lane) {
    const int nblk = Ndst / 64, kb = item / nblk, nb = item % nblk, k0 = 64 * kb, n0 = 64 * nb;
    const int n4 = (lane & 15) * 4, kq = lane >> 4;
    const int src = map_src<TYPE>(n0 + n4);
    const float* wp = W + (size_t)(k0 + kq) * Nsrc + (src >= 0 ? src : 0);
#pragma unroll 8
    for (int it = 0; it < 16; ++it) { const int kk = kq + 4 * it;
        f32x4 v = (src >= 0) ? __builtin_nontemporal_load((const f32x4*)(wp + (size_t)(4 * it) * Nsrc)) : (f32x4){0.f, 0.f, 0.f, 0.f};
        if (HASG) v = v * gain[k0 + kk]; if (HALVE) v = v * 0.5f;
        scr[kk * 64 + ((n4 + 0) ^ kk)] = v.x; scr[kk * 64 + ((n4 + 1) ^ kk)] = v.y; scr[kk * 64 + ((n4 + 2) ^ kk)] = v.z; scr[kk * 64 + ((n4 + 3) ^ kk)] = v.w; }
    asm volatile("s_waitcnt lgkmcnt(0)" ::: "memory");
    const int c = lane & 7;
#pragma unroll
    for (int j = 0; j < 8; ++j) { const int n = (lane >> 3) + 8 * j; float t[8];
#pragma unroll
        for (int i = 0; i < 8; ++i) t[i] = scr[(8 * c + i) * 64 + (n ^ (8 * c + i))];
        v4u o; o.x = pk2(t[0], t[1]); o.y = pk2(t[2], t[3]); o.z = pk2(t[4], t[5]); o.w = pk2(t[6], t[7]);
        *(v4u*)(WT + (size_t)(n0 + n) * K + k0 + 8 * c) = o; }
    asm volatile("s_waitcnt lgkmcnt(0)" ::: "memory");
}
__device__ __forceinline__ void x_row(const float* xrow, bf16* hbrow, float* ssq, int lane) {
    const f32x4* xr = (const f32x4*)xrow + lane;
    f32x4 v[4]; float s = 0.f;
#pragma unroll
    for (int j = 0; j < 4; ++j) { v[j] = xr[64 * j]; s += (v[j].x * v[j].x + v[j].y * v[j].y) + (v[j].z * v[j].z + v[j].w * v[j].w); }
    unsigned long long* o8 = (unsigned long long*)hbrow + lane;
#pragma unroll
    for (int j = 0; j < 4; ++j) o8[64 * j] = (unsigned long long)pk2(v[j].x, v[j].y) | ((unsigned long long)pk2(v[j].z, v[j].w) << 32);
    s = wave_sum(s);
    if (lane < 16) ssq[lane] = (lane == 0) ? s : 0.f;
}
#define CVT_WEIGHTS(LL, WANT_PG, WANT_REST) do                 { \
                    LAS float* scr = (LAS float*)((LAS unsigned char*)lds + wave * 16384); \
                    constexpr int I_GU = 16 * 88, I_DN = 44 * 16, I_IN = 16 * 68, I_CO = 8 * 16, I_UQ = 6 * 24, I_UKV = 4 * 32, I_SQ = 16 * 16, I_PP = 4 * 16; \
                    constexpr int NITEMS = 2 * I_GU + 2 * I_DN + I_IN + I_CO + I_UQ + I_UKV + 3 * I_SQ + I_PP; \
                    const size_t L = (size_t)(LL); \
                    for (int it = gw; it < NITEMS; it += NGW) { \
                        int r = it; \
                        if (r < I_GU) { if (WANT_REST) cvt_item<1, true>(INP(4) + L * 1024 * 5632, INP(3) + L * 1024, 1024, 5632, 5632, (bf16*)(WB + WO_GU1), scr, r, lane); continue; } r -= I_GU; \
                        if (r < I_GU) { if (WANT_REST) cvt_item<1, true>(INP(17) + L * 1024 * 5632, INP(16) + L * 1024, 1024, 5632, 5632, (bf16*)(WB + WO_GU2), scr, r, lane); continue; } r -= I_GU; \
                        if (r < I_DN) { if (WANT_REST) cvt_item<0, false, true>(INP(5) + L * 2816 * 1024, nullptr, 2816, 1024, 1024, (bf16*)(WB + WO_DN1), scr, r, lane); continue; } r -= I_DN; \
                        if (r < I_DN) { if (WANT_REST) cvt_item<0, false, true>(INP(18) + L * 2816 * 1024, nullptr, 2816, 1024, 1024, (bf16*)(WB + WO_DN2), scr, r, lane); continue; } r -= I_DN; \
                        if (r < I_IN) { if (WANT_REST) cvt_item<2, true>(INP(7) + L * 1024 * 4288, INP(6) + L * 1024, 1024, 4288, 4352, (bf16*)(WB + WO_IN), scr, r, lane); continue; } r -= I_IN; \
                        if (r < I_CO) { if (WANT_REST) cvt_item<0, false>(INP(9) + L * 512 * 1024, nullptr, 512, 1024, 1024, (bf16*)(WB + WO_CO), scr, r, lane); continue; } r -= I_CO; \
                        if (r < I_UQ) { if (WANT_REST) cvt_item<3, true>(INP(12) + L * 384 * 1536, INP(10) + L * 384, 384, 1536, 1536, (bf16*)(WB + WO_UQ), scr, r, lane); continue; } r -= I_UQ; \
                        if (r < I_UKV) { if (WANT_REST) cvt_item<4, true>(INP(13) + L * 256 * 2048, INP(11) + L * 256, 256, 2048, 2048, (bf16*)(WB + WO_UKV), scr, r, lane); continue; } r -= I_UKV; \
                        if (r < I_SQ) { if (WANT_REST) cvt_item<0, false>(INP(14) + L * 1024 * 1024, nullptr, 1024, 1024, 1024, (bf16*)(WB + WO_MO), scr, r, lane); continue; } r -= I_SQ; \
                        if (r < I_SQ) { if (WANT_REST) cvt_item<0, false>(INP(15) + L * 1024 * 1024, nullptr, 1024, 1024, 1024, (bf16*)(WB + WO_WO), scr, r, lane); continue; } r -= I_SQ; \
                        if (r < I_SQ) { if (WANT_PG) cvt_item<0, true>(INP(20) + L * 1024 * 1024, INP(19) + L * 1024, 1024, 1024, 1024, (bf16*)(WB + WO_PG), scr, r, lane); continue; } r -= I_SQ; \
                        if (WANT_REST) cvt_item<0, false>(INP(21) + L * 256 * 1024, nullptr, 256, 1024, 1024, (bf16*)(WB + WO_PP), scr, r, lane); \
                    } \
                } while (0)
__global__ void __launch_bounds__(NWAVES * 64, 2) mega_fwd(Args a) {
    extern __shared__ __attribute__((aligned(16))) unsigned char lds[];
    cg::grid_group grid = cg::this_grid();
    const int G = gridDim.x, bx = blockIdx.x, NGW = G * NWAVES;
    const int vcu = (G % 8 == 0) ? (bx % 8) * (G / 8) + bx / 8 : bx;
#define INP(k) ({ int _k = (k); asm volatile("" : "+s"(_k)); a.in[_k]; })
    float* h = a.out;

    for (int u = threadIdx.x; u < (LDS_BYTES - RING_BYTES) / 4; u += NWAVES * 64) ((LAS unsigned*)((LAS unsigned char*)lds + RING_BYTES))[u] = 0u;
    __syncthreads();
    const XcdBarrier bar = xcd_barrier_post((unsigned*)(a.ws + WS_CTL), (volatile LAS unsigned*)((LAS unsigned char*)lds + MISC_OFF) + 8);
    for (int layer = 0; layer < DEPTH; ++layer) {
        for (int step = 0; step < 12; ++step) {
    unsigned char* ws = a.ws; asm volatile("" : "+s"(ws));
    int tid_ = threadIdx.x; asm volatile("" : "+v"(tid_)); const int tid = tid_, lane = tid & 63, wave = __builtin_amdgcn_readfirstlane(tid >> 6), gw = bx * NWAVES + wave;
    float* cosT = (float*)(ws + WS_COS); float* sinT = (float*)(ws + WS_SIN); float* SSQ = (float*)(ws + WS_SSQ);
    bf16* XN = (bf16*)(ws + WS_XN); bf16* CONV = (bf16*)(ws + WS_CONV); bf16* QB = (bf16*)(ws + WS_Q); bf16* PB = (bf16*)(ws + WS_PB); bf16* PP = (bf16*)(ws + WS_PP);
    bf16* LORA = (bf16*)(ws + WS_LORA); bf16* QN = (bf16*)(ws + WS_QN); bf16* KVN = (bf16*)(ws + WS_KVN); bf16* ATT = (bf16*)(ws + WS_ATTN);
    bf16* GATES = (bf16*)(ws + WS_GATES); bf16* YCB = (bf16*)(ws + WS_YCB); bf16* KROPE = (bf16*)(ws + WS_KROPE); bf16* KNOPE = (bf16*)(ws + WS_KNOPE);
    bf16* QNP = (bf16*)((unsigned char*)h + (size_t)MTOK * DM * 2); bf16* QRP = (bf16*)(ws + WS_XN);     float* LSSQ = (float*)(ws + WS_LSSQ); bf16* VB = (bf16*)(ws + WS_V); bf16* HID = (bf16*)(ws + WS_HID); bf16* HB = (bf16*)h;     bf16* HB2 = XN;
    unsigned char* WB = ws + WS_W;
            if (step == 0 && layer > 0) {
                continue;
            } else if (step == 0) {
                CVT_WEIGHTS(layer, true, true);
                if (layer == 0) {
                    const int* pos = (const int*)INP(2);
                    for (int idx = bx * 512 + tid; idx < MTOK * 32; idx += G * 512) {
                        const int m = idx >> 5, i = idx & 31;
                        const float ang = (float)pos[m] * INV_FREQ[i];
                        double rev = (double)ang * 0.15915494309189535; rev -= __builtin_rint(rev);
                        const float rr = (float)(rev * 6.283185307179586);
                        cosT[idx] = __cosf(rr); sinT[idx] = __sinf(rr);
                    }
                    const float* x = INP(0);
                    for (int m = gw; m < MTOK; m += NGW) x_row(x + (size_t)m * DM, HB2 + (size_t)m * DM, SSQ + (size_t)m * 16, lane);
                }
            } else if (step == 4) {
                continue;
            } else if (step == 6) {
                for (int i = 0; i < 1024; ++i) {
                    const int idx = i * G + vcu; if (idx >= 1024) break;
                    const int c = idx & 255, rnd = idx >> 8, bh = c >> 2, s = c & 3;
                    const int qb = (rnd == 0) ? 15 - s : (rnd == 1) ? 11 - s : (rnd == 2) ? 4 + s : s;
                    att::attn_unit(bh >> 3, bh & 7, qb, QNP, QRP, KNOPE, KROPE, VB, ATT, (char*)lds);
                }
            } else {
                if (step == 11 && layer + 1 < DEPTH) { CVT_WEIGHTS(layer + 1, false, true); __syncthreads(); }
                if (step == 1 && layer > 0) { CVT_WEIGHTS(layer, true, false); __syncthreads(); }
                if (step == 5) {
                const float* cw = INP(8) + layer * 3 * 512;
                const int c0 = lane * 8;
                f32x4 w0a = *(const f32x4*)(cw + c0), w0b = *(const f32x4*)(cw + c0 + 4), w1a = *(const f32x4*)(cw + 512 + c0), w1b = *(const f32x4*)(cw + 512 + c0 + 4),
                      w2a = *(const f32x4*)(cw + 1024 + c0), w2b = *(const f32x4*)(cw + 1024 + c0 + 4);
                for (int blk = gw; blk < MTOK / 4; blk += NGW) {
                    const size_t m0 = (size_t)blk * 4; const bool head = ((int)m0 & (SEQ - 1)) == 0;
                    const bf16* cr = CONV + m0 * 1536;
                    f32x4 za[6], zb[6];
#pragma unroll
                    for (int i = 0; i < 6; ++i) {
                        if (i < 2 && head) { za[i] = (f32x4){0.f, 0.f, 0.f, 0.f}; zb[i] = za[i]; }
                        else { f32x4 ca, cb, va, vb; const bf16* rp = cr + (i - 2) * 1536; pg8::unpack8(*(const v4u*)(rp + 512 + c0), ca, cb); pg8::unpack8(*(const v4u*)(rp + 1024 + c0), va, vb); za[i] = ca * va; zb[i] = cb * vb; }
                    }
#pragma unroll
                    for (int r = 0; r < 4; ++r) {
                        const f32x4 ya = w0a * za[r] + w1a * za[r + 1] + w2a * za[r + 2], yb = w0b * zb[r] + w1b * zb[r + 1] + w2b * zb[r + 2];
                        f32x4 ba, bb; pg8::unpack8(*(const v4u*)(cr + r * 1536 + c0), ba, bb);
                        *(v4u*)(YCB + (m0 + r) * 512 + c0) = pg8::pack8(ba * ya, bb * yb);
                    }
                }
                for (int g8 = gw; g8 < MTOK / 8; g8 += NGW) {
                    const size_t m = (size_t)g8 * 8 + (lane >> 3); const int j4 = (lane & 7) * 4;
                    const bf16* lr = LORA + m * 768 + 640;
                    const v2u a1 = *(const v2u*)(lr + j4), a2 = *(const v2u*)(lr + 32 + j4);
                    const f32x4 c = *(const f32x4*)(cosT + m * 32 + j4), s = *(const f32x4*)(sinT + m * 32 + j4);
                    const f32x4 x1 = {pg8::bf_lo(a1.x), pg8::bf_hi(a1.x), pg8::bf_lo(a1.y), pg8::bf_hi(a1.y)}, x2 = {pg8::bf_lo(a2.x), pg8::bf_hi(a2.x), pg8::bf_lo(a2.y), pg8::bf_hi(a2.y)};
                    const f32x4 y1 = x1 * c - x2 * s, y2 = x2 * c + x1 * s;
                    v2u o1, o2; o1.x = pk2(y1.x, y1.y); o1.y = pk2(y1.z, y1.w); o2.x = pk2(y2.x, y2.y); o2.y = pk2(y2.z, y2.w);
                    *(v2u*)(KROPE + m * 64 + j4) = o1; *(v2u*)(KROPE + m * 64 + 32 + j4) = o2;
                }
                }
                if (step == 8) {
                    const float* p = INP(1) + (size_t)layer * MTOK * 256;
                    for (int idx = bx * 512 + tid; idx < MTOK * 256 / 8; idx += G * 512) {
                        const f32x4 x0 = *(const f32x4*)(p + (size_t)idx * 8), x1 = *(const f32x4*)(p + (size_t)idx * 8 + 4);
                        v4u o; o.x = pk2(x0.x, x0.y); o.y = pk2(x0.z, x0.w); o.z = pk2(x1.x, x1.y); o.w = pk2(x1.z, x1.w);
                        *(v4u*)(PB + (size_t)idx * 8) = o;
                    }
                }
                const int ng = (step == 5 || step == 7 || step == 9) ? 2 : 1;
                constexpr size_t SQA = (size_t)MTOK * 16; float* sq0 = SSQ + (size_t)(layer * 4) * SQA;
                for (int gi = 0; gi < ng; ++gi) {
                    pg8::Gemm g; g.M = MTOK; g.lda = 0; pg8::Epi E{}; int sq_off = 0, sq_n4 = 4, sq_stride = 16; float sq_inv = 1.f / DM; E.h = h; E.cosT = cosT; E.sinT = sinT; E.scale = 1.f; E.hb = HB; E.rl = (LAS float*)((LAS unsigned char*)lds + RING_BYTES + 1024);
                    if (step == 1) { g.A = HB2; g.Bt = (const bf16*)(WB + WO_GU1); g.N = 5632; g.K = 1024; E.mode = pg8::EPI_GU; E.o0 = HID; E.ssq_in = sq0; }
                    else if (step == 9 && gi == 0) { g.A = HB; g.Bt = (const bf16*)(WB + WO_GU2); g.N = 5632; g.K = 1024; E.mode = pg8::EPI_GU; E.o0 = HID; E.ssq_in = sq0 + 2 * SQA; }
                    else if (step == 2 || step == 10) { g.A = HID; g.Bt = (const bf16*)(WB + (step == 2 ? WO_DN1 : WO_DN2)); g.N = 1024; g.K = 2816; E.mode = pg8::EPI_RES; E.ssq_out = sq0 + (step == 2 ? 1 : 3) * SQA; E.hsrc = (step == 2) ? HB2 : HB; }
                    else if (step == 3) { g.A = HB; g.Bt = (const bf16*)(WB + WO_IN); g.N = 4352; g.K = 1024; E.mode = pg8::EPI_SPLIT; E.o0 = CONV; E.ld0 = 1536; E.t1 = 6; E.o1 = GATES; E.ld1 = 2048; E.t2 = 14; E.sig1 = 1; E.o2 = LORA; E.ld2 = 768; E.ssq_in = sq0 + SQA; E.lssq = LSSQ; }
                    else if (step == 5 && gi == 0) { g.A = LORA; g.lda = 768; g.Bt = (const bf16*)(WB + WO_UQ); g.N = 1536; g.K = 384; E.mode = pg8::EPI_UQ; E.o0 = QNP; E.o1 = QRP; E.ssq_in = LSSQ; sq_off = 0; sq_n4 = 3; sq_stride = 32; sq_inv = 1.f / 384.f; }
                    else if (step == 5) { g.A = LORA + 384; g.lda = 768; E.ssq_in = LSSQ; sq_off = 12; sq_n4 = 2; sq_stride = 32; sq_inv = 1.f / 256.f; g.Bt = (const bf16*)(WB + WO_UKV); g.N = 2048; g.K = 256; E.mode = pg8::EPI_SPLIT; E.o0 = KNOPE; E.ld0 = 1024; E.t1 = 4; E.o1 = VB; E.ld1 = 1024; E.t2 = 1000; E.o2 = VB; E.ld2 = 1024; }
                    else if (step == 7 && gi == 0) { g.A = ATT; g.Bt = (const bf16*)(WB + WO_MO); g.N = 1024; g.K = 1024; E.mode = pg8::EPI_MO; E.o0 = XN; E.g = GATES; }
                    else if (step == 7) { g.A = YCB; g.Bt = (const bf16*)(WB + WO_CO); g.N = 1024; g.K = 512; E.mode = pg8::EPI_CO; E.o0 = XN; E.g = GATES; }
                    else if (step == 8) { g.A = XN; g.Bt = (const bf16*)(WB + WO_WO); g.N = 1024; g.K = 1024; E.mode = pg8::EPI_RES; E.scale = 1.f; E.ssq_out = sq0 + 2 * SQA; E.hsrc = HB; }
                    else if (step == 9) { g.A = PB; g.Bt = (const bf16*)(WB + WO_PP); g.N = 1024; g.K = 256; E.mode = pg8::EPI_SPLIT; E.o0 = PP; E.ld0 = 1024; E.t1 = 1000; E.t2 = 1000; E.o1 = PP; E.o2 = PP; E.ld1 = 1024; E.ld2 = 1024; }
                    else { g.A = HB; g.Bt = (const bf16*)(WB + WO_PG); g.N = 1024; g.K = 1024; E.mode = pg8::EPI_PLE; E.g = PP; E.ssq_in = sq0 + 3 * SQA; E.ssq_out = sq0 + 4 * SQA; E.hb2 = HB2; }
                    pg8::StaticOrder S; S.init(g.M, g.N, G, bx);
                    if (g.lda == 0) g.lda = g.K;
                    if (E.ssq_in) {
                        pg8::Unit uu;
                        for (int i = 0; S.next(i, uu); ++i)
                            if (tid < 256) { const f32x4* sp = (const f32x4*)(E.ssq_in + (size_t)(uu.pm * 256 + tid) * sq_stride + sq_off); f32x4 s4 = sp[0];
                                for (int q4 = 1; q4 < sq_n4; ++q4) s4 += sp[q4];
                                E.rl[i * 256 + tid] = 1.0f / sqrtf(((s4[0] + s4[1]) + (s4[2] + s4[3])) * sq_inv + EPS); }
                        __syncthreads();
                    }
                    pg8::gemm_phase<pg8::Epi, pg8::StaticOrder, true, true>((LAS unsigned char*)lds, g, S, E);
                }
            }
            if (a.ws == nullptr) grid.sync();     xcd_barrier(bar);
        }
    }
    { const float* gain = INP(22); const int tid = threadIdx.x, lane = tid & 63, wave = __builtin_amdgcn_readfirstlane(tid >> 6), gw = bx * NWAVES + wave;
      const bf16* HB2 = (const bf16*)(a.ws + WS_XN);
      for (int m = gw; m < MTOK; m += NGW) {
          const v4u* xr = (const v4u*)(HB2 + (size_t)m * DM) + lane * 2; f32x4 v[4];
          pg8::unpack8(xr[0], v[0], v[1]); pg8::unpack8(xr[1], v[2], v[3]);
          float s = 0.f;
#pragma unroll
          for (int j = 0; j < 4; ++j) s += (v[j].x * v[j].x + v[j].y * v[j].y) + (v[j].z * v[j].z + v[j].w * v[j].w);
          const float r = 1.0f / sqrtf(wave_sum(s) * (1.f / DM) + EPS);
          const f32x4* gr = (const f32x4*)gain + lane * 4; f32x4* orow = (f32x4*)(h + (size_t)m * DM) + lane * 4;
#pragma unroll
          for (int j = 0; j < 4; ++j) orow[j] = v[j] * r * gr[j];
      } }
}

extern "C" void kernel_launch(void* const* d_in, const int* in_sizes, int n_in, void* d_out, int out_size, void* d_ws, size_t ws_size, hipStream_t stream) {
    static int grid = 0;
    if (grid == 0) {
        if (n_in != 23 || out_size != MTOK * DM || ws_size < WS_END) { fprintf(stderr, "kernel_launch: unexpected shapes: n_in %d out %d ws %zu (need %zu)\n", n_in, out_size, ws_size, (size_t)WS_END); grid = -1; return; }
        int dev = 0, cus = 0, per_cu = 0;
        if (hipGetDevice(&dev) != hipSuccess || hipDeviceGetAttribute(&cus, hipDeviceAttributeMultiprocessorCount, dev) != hipSuccess) { grid = -1; return; }
        if (hipFuncSetAttribute((const void*)mega_fwd, hipFuncAttributeMaxDynamicSharedMemorySize, LDS_BYTES) != hipSuccess) { fprintf(stderr, "kernel_launch: hipFuncSetAttribute failed\n"); grid = -1; return; }
        if (hipOccupancyMaxActiveBlocksPerMultiprocessor(&per_cu, (const void*)mega_fwd, NWAVES * 64, LDS_BYTES) != hipSuccess || per_cu < 1) { fprintf(stderr, "kernel_launch: occupancy query says %d\n", per_cu); per_cu = 1; }
        (void)hipGetLastError();
        grid = cus * per_cu;
    }
    if (grid < 0) return;
    if (hipMemsetAsync((char*)d_ws + WS_CTL, 0, CTL_ZERO_BYTES, stream) != hipSuccess) { fprintf(stderr, "kernel_launch: memset failed\n"); return; }
    Args a{};
    for (int i = 0; i < 23; ++i) a.in[i] = (const float*)d_in[i];
    a.out = (float*)d_out; a.ws = (unsigned char*)d_ws;
    void* args[] = {&a};
    hipError_t e = hipLaunchCooperativeKernel((const void*)mega_fwd, dim3(grid), dim3(NWAVES * 64), args, LDS_BYTES, stream);
    if (e != hipSuccess) fprintf(stderr, "cooperative launch failed: %s (grid %d)\n", hipGetErrorString(e), grid);
}
```
